# Optimizing an MI355X kernel written in HIP

```python
import jax, jax.numpy as jnp
from jax import lax
import numpy as np

D_MODEL = 1024
BATCH = 2
SEQ = 8192
DEPTH = 2
DEC_BATCH = 32
DEC_SEQ = 8
PAST_LEN = 8192
PAGE_SIZE = 128

N_A_LAYERS = DEPTH // 2
N_B_LAYERS = DEPTH - N_A_LAYERS
HEAD_DIM = 64
ROT_DIM = HEAD_DIM // 4
ROPE_THETA = 500000.0
NORM_EPS = 1e-6
A_GROUPS = ((128, 1), (512, 4), (2048, 16))
A_HEADS = 8
A_BLOCK = 128
B_HEADS = 16
B_KV_HEADS = 4
B_GROUP = B_HEADS // B_KV_HEADS
CMP_LEN = 32
CMP_STRIDE = 16
CMP_HIDDEN = 64
SEL_BLOCK = 64
N_SEL = 16
SEL_OVERLAP_W = (1.0, 2.0, 2.0, 2.0, 1.0)
B_WINDOW = 512
Q_BLOCK = 128
PEER_HEADS = 8
PEER_KEYS = 128
PEER_EXPERTS = PEER_KEYS * PEER_KEYS
PEER_QDIM = 256
PEER_TOPK = 16
PEER_CHUNK = 128

kernel_name = 'yoco_dilated_nsa_peer_step'


def rmsnorm(x, g):
    x32 = x.astype(jnp.float32)
    y = x32 * lax.rsqrt(jnp.mean(x32 * x32, axis=-1, keepdims=True) + NORM_EPS)
    return (y * g.astype(jnp.float32)).astype(x.dtype)


def rope(x, pos):
    half = ROT_DIM // 2
    inv = jnp.exp(-jnp.log(jnp.float32(ROPE_THETA)) * jnp.arange(half, dtype=jnp.float32) * (2.0 / ROT_DIM))
    ang = pos.astype(jnp.float32)[:, None] * inv[None, :]
    cos = jnp.cos(ang)[:, None, :].astype(x.dtype)
    sin = jnp.sin(ang)[:, None, :].astype(x.dtype)
    x1 = x[..., :half]
    x2 = x[..., half:ROT_DIM]
    return jnp.concatenate([x1 * cos - x2 * sin, x2 * cos + x1 * sin, x[..., ROT_DIM:]], axis=-1)


def masked_softmax(s, mask):
    s = jnp.where(mask, s.astype(jnp.float32), -jnp.inf)
    m = jnp.max(s, axis=-1, keepdims=True)
    m = jnp.where(jnp.isfinite(m), m, 0.0)
    e = jnp.where(mask, jnp.exp(s - m), 0.0)
    den = jnp.sum(e, axis=-1, keepdims=True)
    p = e / jnp.where(den > 0, den, 1.0)
    lse = (m + jnp.log(den))[..., 0]
    return p, lse


def dilated_attend_prompt(q, k, v, window, dil):
    B, S, H, Dh = q.shape
    nw = window // dil
    L = S // dil
    Lp = -(-L // A_BLOCK) * A_BLOCK
    nb = Lp // A_BLOCK

    def to_residue(x):
        x = x.reshape(B, L, dil, H, Dh).transpose(0, 2, 1, 3, 4)
        return jnp.pad(x, ((0, 0), (0, 0), (0, Lp - L), (0, 0), (0, 0)))

    def band_keys(x):
        prev = jnp.pad(x, ((0, 0), (0, 0), (A_BLOCK, 0), (0, 0), (0, 0)))[:, :, :Lp]
        shp = (B, dil, nb, A_BLOCK, H, Dh)
        return jnp.concatenate([prev.reshape(shp), x.reshape(shp)], axis=3)

    qb = to_residue(q).reshape(B, dil, nb, A_BLOCK, H, Dh)
    kb = band_keys(to_residue(k))
    vb = band_keys(to_residue(v))
    s = jnp.einsum('brnqhd,brnkhd->brnhqk', qb, kb) * (Dh ** -0.5)
    i = jnp.arange(A_BLOCK)[:, None]
    j = jnp.arange(2 * A_BLOCK)[None, :]
    rel = A_BLOCK + i - j
    key_idx = jnp.arange(nb)[:, None, None] * A_BLOCK - A_BLOCK + j[None]
    mask = ((rel >= 0) & (rel <= nw))[None] & (key_idx >= 0)
    p, lse = masked_softmax(s, mask[:, None])
    o = jnp.einsum('brnhqk,brnkhd->brnqhd', p.astype(v.dtype), vb)
    o = o.reshape(B, dil, Lp, H, Dh)[:, :, :L].transpose(0, 2, 1, 3, 4).reshape(B, S, H, Dh)
    lse = lse.transpose(0, 1, 2, 4, 3).reshape(B, dil, Lp, H)[:, :, :L].transpose(0, 2, 1, 3).reshape(B, S, H)
    return o, lse


def dilated_attend_step(q, k_all, v_all, window, dil, n_buf):
    Bd, Sd, H, Dh = q.shape
    nw = window // dil
    idx = n_buf + jnp.arange(Sd)[:, None] - dil * jnp.arange(nw + 1)[None, :]
    valid = idx >= 0
    idx = jnp.maximum(idx, 0)
    kg = k_all[:, idx]
    vg = v_all[:, idx]
    s = jnp.einsum('bqhd,bqjhd->bhqj', q, kg) * (Dh ** -0.5)
    p, lse = masked_softmax(s, valid)
    o = jnp.einsum('bhqj,bqjhd->bqhd', p.astype(v_all.dtype), vg)
    return o, lse.transpose(0, 2, 1)


def mixer_a(h, pos, w_in, w_o, bufs):
    B, T, _ = h.shape
    proj = (h @ w_in).reshape(B, T, len(A_GROUPS), 3, A_HEADS, HEAD_DIM)
    outs, lses, states = [], [], []
    for g, (win, dil) in enumerate(A_GROUPS):
        q = rope(proj[:, :, g, 0], pos)
        k = rope(proj[:, :, g, 1], pos)
        v = proj[:, :, g, 2]
        if bufs is None:
            o, lse = dilated_attend_prompt(q, k, v, win, dil)
            keep = min(win, T)
            states.append(jnp.stack([k[:, T - keep:], v[:, T - keep:]], axis=2))
        else:
            keep = bufs[g].shape[1]
            k_all = jnp.concatenate([bufs[g][:, :, 0], k], axis=1)
            v_all = jnp.concatenate([bufs[g][:, :, 1], v], axis=1)
            o, lse = dilated_attend_step(q, k_all, v_all, win, dil, keep)
            states.append(jnp.stack([k_all, v_all], axis=2)[:, k_all.shape[1] - keep:])
        outs.append(o)
        lses.append(lse)
    wts = jax.nn.softmax(jnp.stack(lses, axis=0), axis=0)
    o = jnp.sum(wts[..., None].astype(h.dtype) * jnp.stack(outs, axis=0), axis=0)
    return o.reshape(B, T, A_HEADS * HEAD_DIM) @ w_o, states


def compress_blocks(k_raw, v_raw, w_cmp1, w_cmp2, pe_cmp):
    B, T = k_raw.shape[:2]
    n_chunk = T // CMP_STRIDE
    kv = jnp.stack([k_raw, v_raw], axis=0)[:, :, :n_chunk * CMP_STRIDE]
    chunks = kv.reshape(2, B, n_chunk, CMP_STRIDE, B_KV_HEADS, HEAD_DIM)
    lo = jnp.einsum('zbclhd,zldf->zbchf', chunks, w_cmp1[:, :CMP_STRIDE])
    hi = jnp.einsum('zbclhd,zldf->zbchf', chunks, w_cmp1[:, CMP_STRIDE:])
    pe_term = jnp.einsum('zld,zldf->zf', pe_cmp, w_cmp1)
    hid = jax.nn.gelu(lo[:, :, :-1] + hi[:, :, 1:] + pe_term[:, None, None, None, :])
    out = jnp.einsum('zbnhf,zfd->zbnhd', hid, w_cmp2)
    end_pos = jnp.arange(n_chunk - 1, dtype=jnp.int32) * CMP_STRIDE + (CMP_LEN - 1)
    return rope(out[0], end_pos), out[1], end_pos


def to_blocks(x):
    B, T = x.shape[:2]
    nsb = -(-T // SEL_BLOCK)
    x = jnp.pad(x, ((0, 0), (0, nsb * SEL_BLOCK - T), (0, 0), (0, 0)))
    return x.reshape(B, nsb, SEL_BLOCK, B_KV_HEADS, HEAD_DIM).transpose(0, 3, 1, 2, 4)


def shared_b_context(x, pos, past, g_kv, w_kv_b, w_cmp1, w_cmp2, pe_cmp, past_rows, win_buf):
    B, T, _ = x.shape
    kv = (rmsnorm(x, g_kv) @ w_kv_b).reshape(B, T, 6, B_KV_HEADS, HEAD_DIM)
    new_rows = jnp.stack([kv[:, :, 0], kv[:, :, 1], rope(kv[:, :, 2], pos), kv[:, :, 3]], axis=2)
    new_win = jnp.stack([rope(kv[:, :, 4], pos), kv[:, :, 5]], axis=2)
    if past_rows is None:
        rows = new_rows
        keep = min(B_WINDOW, T)
        win_state = new_win[:, T - keep:]
        win_all = jnp.pad(new_win, ((0, 0), (B_WINDOW, 0), (0, 0), (0, 0), (0, 0)))
        win_pos0 = -B_WINDOW
    else:
        rows = jnp.concatenate([past_rows, new_rows], axis=1)
        keep = win_buf.shape[1]
        win_all = jnp.concatenate([win_buf, new_win], axis=1)
        win_state = win_all[:, win_all.shape[1] - keep:]
        win_pos0 = past - keep
    kc, vc, cmp_end = compress_blocks(rows[:, :, 0], rows[:, :, 1], w_cmp1, w_cmp2, pe_cmp)
    ctx = {'kc': kc, 'vc': vc, 'cmp_end': cmp_end,
           'ksb': to_blocks(rows[:, :, 2]), 'vsb': to_blocks(rows[:, :, 3]),
           'kw': win_all[:, :, 0], 'vw': win_all[:, :, 1], 'win_pos0': win_pos0}
    return ctx, new_rows, win_state


def nsa_attend(q, gate, qpos, kc, vc, cmp_end, ksb, vsb, kw, vw, wpos):
    B, Q = q.shape[:2]
    scale = HEAD_DIM ** -0.5
    qg = q.reshape(B, Q, B_KV_HEADS, B_GROUP, HEAD_DIM)
    s_c = jnp.einsum('bqhgd,bnhd->bhgqn', qg, kc) * scale
    p_c, _ = masked_softmax(s_c, cmp_end[None, :] <= qpos[:, None])
    o_c = jnp.einsum('bhgqn,bnhd->bqhgd', p_c.astype(vc.dtype), vc)
    n_cmp = kc.shape[1]
    n_sb = ksb.shape[2]
    imp = jnp.sum(p_c, axis=2)
    cidx = (SEL_BLOCK // CMP_STRIDE) * jnp.arange(n_sb)[:, None] - 1 + jnp.arange(len(SEL_OVERLAP_W))[None, :]
    wts = jnp.where((cidx >= 0) & (cidx < n_cmp), jnp.asarray(SEL_OVERLAP_W, jnp.float32), 0.0)
    imp_sel = jnp.einsum('bhqjo,jo->bhqj', imp[..., jnp.clip(cidx, 0, n_cmp - 1)], wts)
    blk = jnp.arange(n_sb)[None, :]
    cur = (qpos // SEL_BLOCK)[:, None]
    forced = (blk == 0) | (blk == cur) | (blk == cur - 1)
    imp_sel = jnp.where(blk > cur, -jnp.inf, jnp.where(forced, jnp.inf, imp_sel))
    _, sel = lax.top_k(imp_sel, min(N_SEL, n_sb))
    n_k = sel.shape[-1]
    bi = jnp.arange(B)[:, None, None, None]
    hi = jnp.arange(B_KV_HEADS)[None, :, None, None]
    kg = ksb[bi, hi, sel]
    vg = vsb[bi, hi, sel]
    tok = sel[..., None] * SEL_BLOCK + jnp.arange(SEL_BLOCK)
    s_s = jnp.einsum('bqhgd,bhqkld->bhgqkl', qg, kg) * scale
    m_s = (tok <= qpos[None, None, :, None, None])[:, :, None]
    flat = (B, B_KV_HEADS, B_GROUP, Q, n_k * SEL_BLOCK)
    p_s, _ = masked_softmax(s_s.reshape(flat), m_s.reshape(B, B_KV_HEADS, 1, Q, n_k * SEL_BLOCK))
    o_s = jnp.einsum('bhgqkl,bhqkld->bqhgd', p_s.reshape(s_s.shape).astype(vg.dtype), vg)
    s_w = jnp.einsum('bqhgd,bkhd->bhgqk', qg, kw) * scale
    rel = qpos[:, None] - wpos[None, :]
    p_w, _ = masked_softmax(s_w, (rel >= 0) & (rel <= B_WINDOW) & (wpos >= 0)[None, :])
    o_w = jnp.einsum('bhgqk,bkhd->bqhgd', p_w.astype(vw.dtype), vw)
    g = gate.reshape(B, Q, B_KV_HEADS, B_GROUP, 3).astype(q.dtype)
    o = g[..., 0:1] * o_c + g[..., 1:2] * o_s + g[..., 2:3] * o_w
    return o.reshape(B, Q, B_HEADS * HEAD_DIM)


def mixer_b(h, pos, ctx, w_qg, b_gate, w_o, is_prompt):
    B, T, _ = h.shape
    qg = h @ w_qg
    q = rope(qg[..., :B_HEADS * HEAD_DIM].reshape(B, T, B_HEADS, HEAD_DIM), pos)
    gate = jax.nn.sigmoid((qg[..., B_HEADS * HEAD_DIM:] + b_gate).astype(jnp.float32)).reshape(B, T, B_HEADS, 3)
    if is_prompt:
        nq = T // Q_BLOCK

        def block_fn(args):
            qb, gb, t0 = args
            qpos = t0 + jnp.arange(Q_BLOCK, dtype=jnp.int32)
            kw = lax.dynamic_slice_in_dim(ctx['kw'], t0, Q_BLOCK + B_WINDOW, axis=1)
            vw = lax.dynamic_slice_in_dim(ctx['vw'], t0, Q_BLOCK + B_WINDOW, axis=1)
            wpos = t0 - B_WINDOW + jnp.arange(Q_BLOCK + B_WINDOW, dtype=jnp.int32)
            return nsa_attend(qb, gb, qpos, ctx['kc'], ctx['vc'], ctx['cmp_end'], ctx['ksb'], ctx['vsb'], kw, vw, wpos)

        qs = q.reshape(B, nq, Q_BLOCK, B_HEADS, HEAD_DIM).swapaxes(0, 1)
        gs = gate.reshape(B, nq, Q_BLOCK, B_HEADS, 3).swapaxes(0, 1)
        t0s = jnp.arange(nq, dtype=jnp.int32) * Q_BLOCK
        o = lax.map(block_fn, (qs, gs, t0s)).swapaxes(0, 1).reshape(B, T, B_HEADS * HEAD_DIM)
    else:
        wpos = ctx['win_pos0'] + jnp.arange(ctx['kw'].shape[1], dtype=jnp.int32)
        o = nsa_attend(q, gate, pos, ctx['kc'], ctx['vc'], ctx['cmp_end'], ctx['ksb'], ctx['vsb'], ctx['kw'], ctx['vw'], wpos)
    return o @ w_o


def peer(h, w_q, subkeys, u, v):
    B, T, D = h.shape
    n = B * T
    n_pad = -(-n // PEER_CHUNK) * PEER_CHUNK
    flat = jnp.pad(h.reshape(n, D), ((0, n_pad - n), (0, 0)))

    def chunk_fn(xc):
        qh = (xc @ w_q).reshape(PEER_CHUNK, PEER_HEADS, 2, PEER_QDIM // 2)
        s = jnp.einsum('thzd,znd->thzn', qh, subkeys).astype(jnp.float32)
        s_top, i_top = lax.top_k(s, PEER_TOPK)
        cand_s = (s_top[:, :, 0, :, None] + s_top[:, :, 1, None, :]).reshape(PEER_CHUNK, PEER_HEADS, PEER_TOPK * PEER_TOPK)
        cand_e = (i_top[:, :, 0, :, None] * PEER_KEYS + i_top[:, :, 1, None, :]).reshape(PEER_CHUNK, PEER_HEADS, PEER_TOPK * PEER_TOPK)
        best_s, best_j = lax.top_k(cand_s, PEER_TOPK)
        e = jnp.take_along_axis(cand_e, best_j, axis=-1)
        g = jax.nn.softmax(best_s, axis=-1)
        act = jax.nn.gelu(jnp.einsum('td,thkd->thk', xc, u[e]).astype(jnp.float32))
        return jnp.einsum('thk,thkd->td', (g * act).astype(xc.dtype), v[e])

    out = lax.map(chunk_fn, flat.reshape(n_pad // PEER_CHUNK, PEER_CHUNK, D))
    return out.reshape(n_pad, D)[:n].reshape(B, T, D)


def trunk(x, past, a_bufs, past_rows, b_win_buf, is_prompt, weights):
    (g_mix, g_ffn, w_in_a, w_o_a, g_kv, w_kv_b, w_cmp1, w_cmp2, pe_cmp,
     w_qg_b, b_gate_b, w_o_b, w_peer_q, peer_subkeys, peer_u, peer_v, g_final) = weights
    B, T, _ = x.shape
    pos = past + jnp.arange(T, dtype=jnp.int32)
    a_state = [[] for _ in A_GROUPS]
    ctx, b_rows, b_win = None, None, None
    for layer in range(DEPTH):
        if layer == N_A_LAYERS:
            ctx, b_rows, b_win = shared_b_context(x, pos, past, g_kv, w_kv_b, w_cmp1, w_cmp2, pe_cmp, past_rows, b_win_buf)
        h = rmsnorm(x, g_mix[layer])
        if layer < N_A_LAYERS:
            bufs = None if a_bufs is None else [c[layer] for c in a_bufs]
            o, new_bufs = mixer_a(h, pos, w_in_a[layer], w_o_a[layer], bufs)
            for g in range(len(A_GROUPS)):
                a_state[g].append(new_bufs[g])
        else:
            lb = layer - N_A_LAYERS
            o = mixer_b(h, pos, ctx, w_qg_b[lb], b_gate_b[lb], w_o_b[lb], is_prompt)
        x = x + o
        x = x + peer(rmsnorm(x, g_ffn[layer]), w_peer_q[layer], peer_subkeys[layer], peer_u[layer], peer_v[layer])
    y = rmsnorm(x, g_final)
    return y, [jnp.stack(s, axis=0) for s in a_state], b_rows, b_win


def setup_inputs(seed: int = 0) -> dict:
    key = jax.random.key(seed)
    ks = jax.random.split(key, 32)
    f32 = jnp.float32

    def nrm(k, shape, scale):
        return jax.random.normal(k, shape, f32) * scale

    n_pages = PAST_LEN // PAGE_SIZE
    n_used = DEC_BATCH * n_pages
    n_phys = n_used + max(1, n_used // 4)
    page_table = jax.random.permutation(ks[0], n_phys)[:n_used].reshape(DEC_BATCH, n_pages).astype(jnp.int32)

    def a_shape(w):
        return (N_A_LAYERS, DEC_BATCH, min(w, PAST_LEN), 2, A_HEADS, HEAD_DIM)

    return {
        'x_prompt': nrm(ks[1], (BATCH, SEQ, D_MODEL), 1.0),
        'x_sample': nrm(ks[2], (DEC_BATCH, DEC_SEQ, D_MODEL), 1.0),
        'cache_a_g1': nrm(ks[3], a_shape(A_GROUPS[0][0]), 1.0),
        'cache_a_g2': nrm(ks[4], a_shape(A_GROUPS[1][0]), 1.0),
        'cache_a_g3': nrm(ks[5], a_shape(A_GROUPS[2][0]), 1.0),
        'cache_b_kv': nrm(ks[6], (n_phys, PAGE_SIZE, 4, B_KV_HEADS, HEAD_DIM), 1.0),
        'cache_b_win': nrm(ks[7], (DEC_BATCH, min(B_WINDOW, PAST_LEN), 2, B_KV_HEADS, HEAD_DIM), 1.0),
        'page_table': page_table,
        'g_mix': 1.0 + nrm(ks[8], (DEPTH, D_MODEL), 0.02),
        'g_ffn': 1.0 + nrm(ks[9], (DEPTH, D_MODEL), 0.02),
        'w_in_a': nrm(ks[10], (N_A_LAYERS, D_MODEL, len(A_GROUPS) * 3 * A_HEADS * HEAD_DIM), D_MODEL ** -0.5),
        'w_o_a': nrm(ks[11], (N_A_LAYERS, A_HEADS * HEAD_DIM, D_MODEL), (A_HEADS * HEAD_DIM) ** -0.5),
        'g_kv': 1.0 + nrm(ks[12], (D_MODEL,), 0.02),
        'w_kv_b': nrm(ks[13], (D_MODEL, 6 * B_KV_HEADS * HEAD_DIM), D_MODEL ** -0.5),
        'w_cmp1': nrm(ks[14], (2, CMP_LEN, HEAD_DIM, CMP_HIDDEN), (CMP_LEN * HEAD_DIM) ** -0.5),
        'w_cmp2': nrm(ks[15], (2, CMP_HIDDEN, HEAD_DIM), CMP_HIDDEN ** -0.5),
        'pe_cmp': nrm(ks[16], (2, CMP_LEN, HEAD_DIM), 0.1),
        'w_qg_b': nrm(ks[17], (N_B_LAYERS, D_MODEL, B_HEADS * HEAD_DIM + 3 * B_HEADS), D_MODEL ** -0.5),
        'b_gate_b': nrm(ks[18], (N_B_LAYERS, 3 * B_HEADS), 0.02),
        'w_o_b': nrm(ks[19], (N_B_LAYERS, B_HEADS * HEAD_DIM, D_MODEL), (B_HEADS * HEAD_DIM) ** -0.5),
        'w_peer_q': nrm(ks[20], (DEPTH, D_MODEL, PEER_HEADS * PEER_QDIM), D_MODEL ** -0.5),
        'peer_subkeys': nrm(ks[21], (DEPTH, 2, PEER_KEYS, PEER_QDIM // 2), (PEER_QDIM // 2) ** -0.5),
        'peer_u': nrm(ks[22], (DEPTH, PEER_EXPERTS, D_MODEL), D_MODEL ** -0.5),
        'peer_v': nrm(ks[23], (DEPTH, PEER_EXPERTS, D_MODEL), (PEER_HEADS * PEER_TOPK) ** -0.5),
        'g_final': 1.0 + nrm(ks[24], (D_MODEL,), 0.02),
    }


def reference(x_prompt, x_sample, cache_a_g1, cache_a_g2, cache_a_g3, cache_b_kv, cache_b_win, page_table,
              g_mix, g_ffn, w_in_a, w_o_a, g_kv, w_kv_b, w_cmp1, w_cmp2, pe_cmp,
              w_qg_b, b_gate_b, w_o_b, w_peer_q, peer_subkeys, peer_u, peer_v, g_final):
    weights = (g_mix, g_ffn, w_in_a, w_o_a, g_kv, w_kv_b, w_cmp1, w_cmp2, pe_cmp,
               w_qg_b, b_gate_b, w_o_b, w_peer_q, peer_subkeys, peer_u, peer_v, g_final)
    y_prompt, a_p, bkv_p, bwin_p = trunk(x_prompt, 0, None, None, None, True, weights)
    dec_b, n_pages = page_table.shape
    past = n_pages * cache_b_kv.shape[1]
    past_rows = cache_b_kv[page_table].reshape(dec_b, past, 4, B_KV_HEADS, HEAD_DIM)
    y_sample, a_s, bkv_s, bwin_s = trunk(x_sample, past, (cache_a_g1, cache_a_g2, cache_a_g3),
                                         past_rows, cache_b_win, False, weights)
    return (y_prompt, y_sample, a_p[0], a_s[0], a_p[1], a_s[1], a_p[2], a_s[2], bkv_p, bkv_s, bwin_p, bwin_s)
```

```cpp
#include <hip/hip_runtime.h>
#include <stdint.h>
#include <stdio.h>

#ifndef FUSED
#define FUSED 1
#define FLOAT_WORK 1
#endif
#ifndef PROBE_NSA_ONLY
#define PROBE_NSA_ONLY 0
#endif
#ifndef PROBE_NSA_VARIANT
#define PROBE_NSA_VARIANT 0
#endif
#ifndef PROBE_P0_VARIANT
#define PROBE_P0_VARIANT 0
#endif
#ifndef PROBE_DUP
#define PROBE_DUP 0
#endif

typedef unsigned short bf16_t;
typedef short bf16x8 __attribute__((ext_vector_type(8)));
typedef short bf16x4 __attribute__((ext_vector_type(4)));
typedef float f32x4 __attribute__((ext_vector_type(4)));
typedef unsigned u32x4 __attribute__((ext_vector_type(4)));
typedef unsigned u32x2 __attribute__((ext_vector_type(2)));
#define DI __device__ __forceinline__
#define MFMA16(a, b, c) __builtin_amdgcn_mfma_f32_16x16x32_bf16((a), (b), (c), 0, 0, 0)
typedef int i32x4 __attribute__((ext_vector_type(4)));
#define MFMA_I8(a, b, c) __builtin_amdgcn_mfma_i32_16x16x64_i8((a), (b), (c), 0, 0, 0)
#define NEG_INF (-__builtin_inff())
#define POS_INF (__builtin_inff())

constexpr int D = 1024, SEQ = 8192, NBP = 2, MP = NBP * SEQ, BD = 32, SD = 8, MS = BD * SD, M = MP + MS;
constexpr int PAST = 8192, NPAGE = 64;
constexpr int N_IN = 4608, N_PQ = 2048, N_KVQG = 2688, N_KV = 1536;
constexpr int NEXP = 16384;
constexpr float QSCALE = 0.18033688011112042f;

constexpr size_t O_YP = 0;
constexpr size_t O_YS = O_YP + (size_t)MP * D;
constexpr size_t O_A1P = O_YS + (size_t)MS * D;
constexpr size_t O_A1S = O_A1P + (size_t)NBP * 128 * 1024;
constexpr size_t O_A2P = O_A1S + (size_t)BD * 128 * 1024;
constexpr size_t O_A2S = O_A2P + (size_t)NBP * 512 * 1024;
constexpr size_t O_A3P = O_A2S + (size_t)BD * 512 * 1024;
constexpr size_t O_A3S = O_A3P + (size_t)NBP * 2048 * 1024;
constexpr size_t O_BKVP = O_A3S + (size_t)BD * 2048 * 1024;
constexpr size_t O_BKVS = O_BKVP + (size_t)MP * 1024;
constexpr size_t O_BWP = O_BKVS + (size_t)MS * 1024;
constexpr size_t O_BWS = O_BWP + (size_t)NBP * 512 * 512;
constexpr size_t O_END = O_BWS + (size_t)BD * 512 * 512;

constexpr size_t al256(size_t x) { return (x + 255) & ~(size_t)255; }
constexpr size_t W_CTL = 0;
constexpr size_t W_ROWSS = 65536;
constexpr size_t W_CMIN = 200704;
constexpr size_t W_CMKV = W_CMIN + (size_t)N_IN * 4;
constexpr size_t W_WTIN = 262144;
constexpr size_t W_WTOA = W_WTIN + al256((size_t)N_IN * 1024 * 2);
constexpr size_t W_WTPQ = W_WTOA + al256((size_t)1024 * 512 * 2);
constexpr size_t W_WTKVQG = W_WTPQ + al256((size_t)2 * N_PQ * 1024 * 2);
constexpr size_t W_WTOB = W_WTKVQG + al256((size_t)N_KVQG * 1024 * 2);
constexpr size_t W_SUBK = W_WTOB + al256((size_t)1024 * 1024 * 2);
constexpr size_t W_U8 = W_SUBK + al256((size_t)2 * 2 * 128 * 128 * 2);
constexpr size_t W_V8 = W_U8 + al256((size_t)2 * NEXP * 1024);
constexpr size_t W_SU = W_V8 + al256((size_t)2 * NEXP * 1024);
constexpr size_t W_SV = W_SU + al256((size_t)2 * NEXP * 4);
constexpr size_t W_WC1 = W_SV + al256((size_t)2 * NEXP * 4);
constexpr size_t W_WC2 = W_WC1 + al256((size_t)2 * 64 * 2048 * 2);
constexpr size_t W_PET = W_WC2 + al256((size_t)2 * 64 * 64 * 2);
constexpr size_t W_ROPE = W_PET + al256((size_t)2 * 64 * 4);
constexpr size_t W_XHAT = W_ROPE + al256((size_t)8200 * 8 * 2 * 4);
constexpr size_t W_XR = W_XHAT + al256((size_t)M * 1024 * 2);
constexpr size_t W_QA = W_XR + al256((size_t)M * 1024 * 4);
constexpr size_t W_KA = W_QA + al256((size_t)M * 1536 * 2);
constexpr size_t W_VAT = W_KA + al256((size_t)3 * 2 * 8 * 8192 * 64 * 2);
constexpr size_t W_OA = W_VAT + al256((size_t)3 * 2 * 8 * 8192 * 64 * 2);
constexpr size_t W_QH = W_OA + al256((size_t)M * 512 * 2);
constexpr size_t W_CMPK = W_QH + al256((size_t)M * 2048 * 2);
constexpr size_t W_CMPV = W_CMPK + al256((size_t)2 * 8192 * 256 * 2);
constexpr size_t W_SELK = W_CMPV + al256((size_t)2 * 8192 * 256 * 2);
constexpr size_t W_SELVT = W_SELK + al256((size_t)2 * 8192 * 256 * 2);
constexpr size_t W_WINK = W_SELVT + al256((size_t)2 * 8192 * 256 * 2);
constexpr size_t W_WINVT = W_WINK + al256((size_t)2 * 8192 * 256 * 2);
constexpr size_t W_QB = W_WINVT + al256((size_t)2 * 8192 * 256 * 2);
constexpr size_t W_GATE = W_QB + al256((size_t)M * 1024 * 2);
constexpr size_t W_KC = W_GATE + al256((size_t)M * 48 * 4);
constexpr size_t W_VCT = W_KC + al256((size_t)34 * 4 * 512 * 64 * 2);
constexpr size_t W_OB = W_VCT + al256((size_t)34 * 4 * 512 * 64 * 2);
constexpr size_t W_SELE = W_OB + al256((size_t)M * 1024 * 2);
constexpr size_t W_SELG = W_SELE + al256((size_t)M * 128 * 2);
constexpr size_t W_SELU = W_SELG + al256((size_t)M * 128 * 4);
constexpr size_t W_XQ = W_SELU + al256((size_t)M * 128 * 4);
constexpr size_t W_SA = W_XQ + al256((size_t)M * 1024);
constexpr size_t W_SWIN = W_SA + al256((size_t)M * 4);
constexpr size_t W_SWKV = W_SWIN + al256((size_t)N_IN * 4);
constexpr size_t W_SWPQ = W_SWKV + al256((size_t)N_KVQG * 4);
constexpr size_t W_END = W_SWPQ + al256((size_t)2 * N_PQ * 4);

constexpr int CTL_CNT_WORD = 4096;
constexpr int NTHREADS = 256;
constexpr int SMEM_BYTES = 74240;

struct Params {
    const float* x_prompt; const float* x_sample; const float* cache_a0; const float* cache_a1; const float* cache_a2;
    const float* cache_b_kv; const float* cache_b_win; const int* page_table;
    const float* g_mix; const float* g_ffn; const float* w_in_a; const float* w_o_a; const float* g_kv; const float* w_kv_b;
    const float* w_cmp1; const float* w_cmp2; const float* pe_cmp; const float* w_qg_b; const float* b_gate_b; const float* w_o_b;
    const float* w_peer_q; const float* peer_subkeys; const float* peer_u; const float* peer_v; const float* g_final;
    float* out; unsigned char* ws;
};

typedef __bf16 bf16v2 __attribute__((ext_vector_type(2)));
typedef float f32v2 __attribute__((ext_vector_type(2)));
DI unsigned pk2(float a, float b) { const f32v2 v = {a, b}; return __builtin_bit_cast(unsigned, __builtin_convertvector(v, bf16v2)); }
DI unsigned f2bf(float x) { return pk2(x, 0.f) & 0xffffu; }
DI float bf2f(unsigned h) { return __uint_as_float(h << 16); }
DI bf16x8 pack8(float a0, float a1, float a2, float a3, float a4, float a5, float a6, float a7) {
    u32x4 u; u.x = pk2(a0, a1); u.y = pk2(a2, a3); u.z = pk2(a4, a5); u.w = pk2(a6, a7); return __builtin_bit_cast(bf16x8, u);
}
DI float fexp2(float x) { return __builtin_amdgcn_exp2f(x); }
DI float gelu_tanh(float x) {
    const float y = 0.7978845608028654f * (x + 0.044715f * x * x * x);
    const float e = __expf(2.0f * y);
    const float t = 1.0f - 2.0f / (e + 1.0f);
    return 0.5f * x * (1.0f + t);
}
DI int otid() { int t = threadIdx.x; asm volatile("" : "+v"(t)); return t; }
DI int pos_of_row(int row) { return row < MP ? (row & (SEQ - 1)) : PAST + ((row - MP) & 7); }
DI void wave_lds_sync() { asm volatile("s_waitcnt lgkmcnt(0)" ::: "memory"); __builtin_amdgcn_wave_barrier(); asm volatile("" ::: "memory"); }
DI void lds_barrier() { asm volatile("s_waitcnt lgkmcnt(0)" ::: "memory"); __builtin_amdgcn_s_barrier(); asm volatile("" ::: "memory"); }
DI float wave_sum(float v) {
#pragma unroll
    for (int off = 32; off >= 1; off >>= 1) v += __shfl_xor(v, off);
    return v;
}

#define XB_TMO      128
#define XB_XCNT(j)  (256  + 64 * (j))
#define XB_XSUB(j)  (1280 + 64 * (j))
#define XB_XGEN(j)  (2304 + 64 * (j))
#define XB_TOP      3328
#define XB_TOPGEN   3392
#define XCD_BAR_WORDS 3456
#define XB_SPIN_CAP (1u << 22)
#define LAS __attribute__((address_space(3)))

__device__ __forceinline__ unsigned xb_ld(unsigned* p)              { return __hip_atomic_load(p, __ATOMIC_RELAXED, __HIP_MEMORY_SCOPE_AGENT); }
__device__ __forceinline__ unsigned xb_add(unsigned* p, unsigned v) { return __hip_atomic_fetch_add(p, v, __ATOMIC_RELAXED, __HIP_MEMORY_SCOPE_AGENT); }
__device__ __forceinline__ unsigned xb_xcc_id() { return (unsigned)__builtin_amdgcn_s_getreg((3 << 11) | 20) & 0xFu; }
#define XB_SPIN(cond, bar) do { unsigned _sp = 0; while (cond) { __builtin_amdgcn_s_sleep(1); \
    if ((++_sp & 255u) == 0u) { if (xb_ld(&(bar)[XB_TMO])) break; if (_sp > XB_SPIN_CAP) { atomicAdd(&(bar)[XB_TMO], 1u); break; } } } } while (0)

struct XcdBarrier { unsigned* bar; unsigned x; volatile LAS unsigned* st; };

__device__ __forceinline__ XcdBarrier xcd_barrier_post(unsigned* bar, volatile LAS unsigned* st) {
    XcdBarrier b; b.bar = bar; b.x = xb_xcc_id(); b.st = st;
    if (threadIdx.x == 0) (void)xb_add(&bar[XB_XCNT(b.x)], 1u);
    return b;
}
__device__ __forceinline__ void xcd_barrier_complete(unsigned* bar, unsigned x, unsigned& nloc, unsigned& nx) {
    const unsigned G = gridDim.x * gridDim.y * gridDim.z;
    unsigned sum, cnt, mine, sp = 0u;
    for (;;) {
        sum = 0u; cnt = 0u; mine = 0u;
#pragma unroll
        for (unsigned j = 0; j < 16; ++j) { const unsigned c = xb_ld(&bar[XB_XCNT(j)]); sum += c; cnt += (c > 0u) ? 1u : 0u; mine = (j == x) ? c : mine; }
        if (sum == G) break;
        __builtin_amdgcn_s_sleep(1);
        if ((++sp & 255u) == 0u) { if (xb_ld(&bar[XB_TMO])) break; if (sp > XB_SPIN_CAP) { atomicAdd(&bar[XB_TMO], 1u); break; } }
    }
    nloc = mine > 0u ? mine : 1u; nx = cnt > 0u ? cnt : 1u;
}
__device__ __forceinline__ void xcd_barrier(const XcdBarrier& b) {
    asm volatile("s_waitcnt vmcnt(0)" ::: "memory");
    __syncthreads();
    if (threadIdx.x == 0) {
        unsigned* bar = b.bar;
        __builtin_amdgcn_s_waitcnt(0);
        unsigned nloc = b.st[0], nx = b.st[1];
        if (nloc == 0u) { xcd_barrier_complete(bar, b.x, nloc, nx); b.st[0] = nloc; b.st[1] = nx; }
        const unsigned old = xb_add(&bar[XB_XSUB(b.x)], 1u);
        const unsigned gen = old / nloc;
        if (old + 1u == (gen + 1u) * nloc) {
            __builtin_amdgcn_fence(__ATOMIC_RELEASE, "agent");
            asm volatile("s_waitcnt vmcnt(0)" ::: "memory");
            const unsigned og = xb_add(&bar[XB_TOP], 1u);
            const unsigned tg = og / nx;
            if (og + 1u == (tg + 1u) * nx) xb_add(&bar[XB_TOPGEN], 1u);
            else XB_SPIN(xb_ld(&bar[XB_TOPGEN]) == tg, bar);
            __builtin_amdgcn_fence(__ATOMIC_ACQUIRE, "agent");
            xb_add(&bar[XB_XGEN(b.x)], 1u);
            asm volatile("s_waitcnt vmcnt(0)" ::: "memory");
        } else {
            XB_SPIN(xb_ld(&bar[XB_XGEN(b.x)]) == gen, bar);
            __builtin_amdgcn_fence(__ATOMIC_ACQUIRE, "agent");
            asm volatile("s_waitcnt vmcnt(0)" ::: "memory");
        }
    }
    __syncthreads();
}

DI int wave_next(unsigned* cnt, int lane) {
    int u = 0;
    if (lane == 0) u = (int)__hip_atomic_fetch_add(cnt, 1u, __ATOMIC_RELAXED, __HIP_MEMORY_SCOPE_AGENT);
    return __builtin_amdgcn_readfirstlane(u);
}

DI void transpose_cvt(const float* __restrict__ W, int K, int N, bf16_t* __restrict__ Wt, const float* __restrict__ gain, float* tile) {
    const int ntk = K >> 6, ntn = (N + 63) >> 6, tid = otid();
    for (int t = blockIdx.x; t < ntk * ntn; t += gridDim.x) {
        const int tk = t / ntn, tn = t - tk * ntn;
        float4 v[4];
#pragma unroll
        for (int i = 0; i < 4; ++i) {
            const int id = tid + 256 * i, kr = id >> 4, n4 = (id & 15) * 4;
            const int k = tk * 64 + kr, n = tn * 64 + n4;
            v[i] = (n < N) ? *(const float4*)(W + (size_t)k * N + n) : make_float4(0.f, 0.f, 0.f, 0.f);
            if (gain) { const float g = gain[k]; v[i].x *= g; v[i].y *= g; v[i].z *= g; v[i].w *= g; }
        }
#pragma unroll
        for (int i = 0; i < 4; ++i) {
            const int id = tid + 256 * i, kr = id >> 4, n4 = (id & 15) * 4;
            tile[(n4 + 0) * 65 + kr] = v[i].x; tile[(n4 + 1) * 65 + kr] = v[i].y; tile[(n4 + 2) * 65 + kr] = v[i].z; tile[(n4 + 3) * 65 + kr] = v[i].w;
        }
        __syncthreads();
#pragma unroll
        for (int i = 0; i < 2; ++i) {
            const int id = tid + 256 * i, nr = id >> 3, k8 = (id & 7) * 8;
            const int n = tn * 64 + nr;
            if (n < N) {
                const float* tp = tile + nr * 65 + k8;
                u32x4 o; o.x = pk2(tp[0], tp[1]); o.y = pk2(tp[2], tp[3]); o.z = pk2(tp[4], tp[5]); o.w = pk2(tp[6], tp[7]);
                *(u32x4*)(Wt + (size_t)n * K + tk * 64 + k8) = o;
            }
        }
        __syncthreads();
    }
}
DI void colmax_pass(const float* __restrict__ W, int K, int N, const float* __restrict__ gain, unsigned* __restrict__ cm) {
    const int ncg = (N + 255) >> 8, nkc = K >> 6, tid = otid();
    for (int u = blockIdx.x; u < ncg * nkc; u += gridDim.x) {
        const int kc = u / ncg, n = (u - kc * ncg) * 256 + tid;
        if (n < N) {
            float m = 0.f;
#pragma unroll 8
            for (int k = kc * 64; k < kc * 64 + 64; ++k) m = fmaxf(m, fabsf(W[(size_t)k * N + n] * gain[k]));
            atomicMax(cm + n, __float_as_uint(m));
        }
    }
}
DI void transpose_q8(const float* __restrict__ W, int K, int N, unsigned char* __restrict__ Wq, float* __restrict__ sw, const float* __restrict__ gain,
                     const unsigned* __restrict__ cm, float* tile) {
    const int ntk = K >> 6, ntn = (N + 63) >> 6, tid = otid();
    for (int t = blockIdx.x; t < ntk * ntn; t += gridDim.x) {
        const int tk = t / ntn, tn = t - tk * ntn;
        float4 v[4];
#pragma unroll
        for (int i = 0; i < 4; ++i) {
            const int id = tid + 256 * i, kr = id >> 4, n4 = (id & 15) * 4;
            const int k = tk * 64 + kr, n = tn * 64 + n4;
            v[i] = (n < N) ? *(const float4*)(W + (size_t)k * N + n) : make_float4(0.f, 0.f, 0.f, 0.f);
            const float g = gain[k]; v[i].x *= g; v[i].y *= g; v[i].z *= g; v[i].w *= g;
        }
#pragma unroll
        for (int i = 0; i < 4; ++i) {
            const int id = tid + 256 * i, kr = id >> 4, n4 = (id & 15) * 4;
            tile[(n4 + 0) * 65 + kr] = v[i].x; tile[(n4 + 1) * 65 + kr] = v[i].y; tile[(n4 + 2) * 65 + kr] = v[i].z; tile[(n4 + 3) * 65 + kr] = v[i].w;
        }
        __syncthreads();
        {
            const int nr = tid >> 2, k16 = (tid & 3) * 16, n = tn * 64 + nr;
            if (n < N) {
                const float cmx = __uint_as_float(cm[n]);
                const float inv = cmx > 0.f ? 127.0f / cmx : 0.f;
                const float* tp = tile + nr * 65 + k16;
                u32x4 o;
#pragma unroll
                for (int i = 0; i < 4; ++i) {
                    const int a = (int)rintf(tp[4 * i] * inv), b = (int)rintf(tp[4 * i + 1] * inv), c2 = (int)rintf(tp[4 * i + 2] * inv), d = (int)rintf(tp[4 * i + 3] * inv);
                    o[i] = (unsigned)(a & 255) | ((unsigned)(b & 255) << 8) | ((unsigned)(c2 & 255) << 16) | ((unsigned)(d & 255) << 24);
                }
                *(u32x4*)(Wq + (size_t)n * K + tk * 64 + k16) = o;
                if (tk == 0 && k16 == 0) sw[n] = cmx > 0.f ? cmx * (1.0f / 127.0f) : 1.0f;
            }
        }
        __syncthreads();
    }
}
DI void quant_weight_strips(const float* __restrict__ W, int N, unsigned char* __restrict__ Wq, float* __restrict__ sw, const float* __restrict__ gain, float* tile) {
    constexpr int K = 1024, TP = 1028;
    const int tid = otid();
    for (int u = blockIdx.x; u < (N >> 4); u += gridDim.x) {
        const int n0 = u * 16;
#pragma unroll 4
        for (int i = 0; i < 16; ++i) {
            const int id = tid + 256 * i, k = id >> 2, part = id & 3;
            float4 v = *(const float4*)(W + (size_t)k * N + n0 + part * 4);
            const float g = gain[k];
            tile[(part * 4 + 0) * TP + k] = v.x * g; tile[(part * 4 + 1) * TP + k] = v.y * g; tile[(part * 4 + 2) * TP + k] = v.z * g; tile[(part * 4 + 3) * TP + k] = v.w * g;
        }
        __syncthreads();
        {
            const int n = tid >> 4, l16 = tid & 15;
            const float* tp = tile + n * TP + l16 * 64;
            float am = 0.f;
#pragma unroll 8
            for (int i = 0; i < 64; ++i) am = fmaxf(am, fabsf(tp[i]));
#pragma unroll
            for (int off = 1; off < 16; off <<= 1) am = fmaxf(am, __shfl_xor(am, off));
            const float inv = am > 0.f ? 127.0f / am : 0.f;
#pragma unroll
            for (int c4 = 0; c4 < 4; ++c4) {
                u32x4 o;
#pragma unroll
                for (int i = 0; i < 4; ++i) {
                    const float* q = tp + c4 * 16 + 4 * i;
                    const int a = (int)rintf(q[0] * inv), b = (int)rintf(q[1] * inv), c2 = (int)rintf(q[2] * inv), d = (int)rintf(q[3] * inv);
                    o[i] = (unsigned)(a & 255) | ((unsigned)(b & 255) << 8) | ((unsigned)(c2 & 255) << 16) | ((unsigned)(d & 255) << 24);
                }
                *(u32x4*)(Wq + (size_t)(n0 + n) * K + l16 * 64 + c4 * 16) = o;
            }
            if (l16 == 0) sw[n0 + n] = am > 0.f ? am * (1.0f / 127.0f) : 1.0f;
        }
        __syncthreads();
    }
}
DI void norm_rows_q8(const float* __restrict__ srcP, const float* __restrict__ srcS, unsigned char* __restrict__ xq, float* __restrict__ sa) {
    const int lane = otid() & 63, gw = blockIdx.x * (NTHREADS / 64) + (otid() >> 6), nw = gridDim.x * (NTHREADS / 64);
    for (int row = gw; row < M; row += nw) {
        const float* src = (row < MP ? srcP + (size_t)row * D : srcS + (size_t)(row - MP) * D) + lane * 16;
        float4 v[4]; float ss = 0.f, am = 0.f;
#pragma unroll
        for (int i = 0; i < 4; ++i) { v[i] = ((const float4*)src)[i]; ss += v[i].x * v[i].x + v[i].y * v[i].y + v[i].z * v[i].z + v[i].w * v[i].w;
            am = fmaxf(am, fmaxf(fmaxf(fabsf(v[i].x), fabsf(v[i].y)), fmaxf(fabsf(v[i].z), fabsf(v[i].w)))); }
        ss = wave_sum(ss);
#pragma unroll
        for (int off = 32; off >= 1; off >>= 1) am = fmaxf(am, __shfl_xor(am, off));
        const float rs = rsqrtf(ss * (1.0f / D) + 1e-6f), inv = am > 0.f ? 127.0f / am : 0.f;
        u32x4 o;
#pragma unroll
        for (int i = 0; i < 4; ++i) {
            const int a = (int)rintf(v[i].x * inv), b = (int)rintf(v[i].y * inv), c2 = (int)rintf(v[i].z * inv), d = (int)rintf(v[i].w * inv);
            o[i] = (unsigned)(a & 255) | ((unsigned)(b & 255) << 8) | ((unsigned)(c2 & 255) << 16) | ((unsigned)(d & 255) << 24);
        }
        *(u32x4*)(xq + (size_t)row * D + lane * 16) = o;
        if (lane == 0) sa[row] = rs * am * (1.0f / 127.0f);
    }
}
DI void cvt_flat(const float* __restrict__ src, bf16_t* __restrict__ dst, size_t n4) {
    const size_t stride = (size_t)gridDim.x * NTHREADS;
    for (size_t i = (size_t)blockIdx.x * NTHREADS + otid(); i < n4; i += stride) {
        const float4 v = ((const float4*)src)[i];
        u32x2 o; o.x = pk2(v.x, v.y); o.y = pk2(v.z, v.w);
        ((u32x2*)dst)[i] = o;
    }
}
DI void quant_rows(const float* __restrict__ src, unsigned char* __restrict__ dst, float* __restrict__ scale, int nrows, int offset, const float* __restrict__ cgain = nullptr) {
    const int lane = otid() & 63, gw = blockIdx.x * (NTHREADS / 64) + (otid() >> 6), nw = gridDim.x * (NTHREADS / 64);
    for (int row = gw; row < nrows; row += nw) {
        const float4* sp = (const float4*)(src + (size_t)row * 1024 + lane * 16);
        float4 v[4]; float am = 0.f;
#pragma unroll
        for (int i = 0; i < 4; ++i) { v[i] = sp[i];
            if (cgain) { const float4 g = ((const float4*)(cgain + lane * 16))[i]; v[i].x *= g.x; v[i].y *= g.y; v[i].z *= g.z; v[i].w *= g.w; }
            am = fmaxf(am, fmaxf(fmaxf(fabsf(v[i].x), fabsf(v[i].y)), fmaxf(fabsf(v[i].z), fabsf(v[i].w)))); }
#pragma unroll
        for (int off = 32; off >= 1; off >>= 1) am = fmaxf(am, __shfl_xor(am, off));
        const float inv = am > 0.f ? 127.0f / am : 0.f;
        u32x4 o;
#pragma unroll
        for (int i = 0; i < 4; ++i) {
            const int a = (int)rintf(v[i].x * inv) + offset, b = (int)rintf(v[i].y * inv) + offset, c2 = (int)rintf(v[i].z * inv) + offset, d = (int)rintf(v[i].w * inv) + offset;
            o[i] = (unsigned)(a & 255) | ((unsigned)(b & 255) << 8) | ((unsigned)(c2 & 255) << 16) | ((unsigned)(d & 255) << 24);
        }
        *(u32x4*)(dst + (size_t)row * 1024 + lane * 16) = o;
        if (lane == 0) scale[row] = am > 0.f ? am * (1.0f / 127.0f) : 1.0f;
    }
}
DI void quant_rows_part(const float* __restrict__ src, unsigned char* __restrict__ dst, float* __restrict__ scale, int nrows, const float* __restrict__ cgain, int bidx, int nblk) {
    const int lane = otid() & 63, gw = bidx * (NTHREADS / 64) + (otid() >> 6), nw = nblk * (NTHREADS / 64);
    for (int row = gw; row < nrows; row += 2 * nw) {
        const int rowb = (row + nw < nrows) ? row + nw : row;
        const f32x4* spa = (const f32x4*)(src + (size_t)row * 1024 + lane * 16);
        const f32x4* spb = (const f32x4*)(src + (size_t)rowb * 1024 + lane * 16);
        f32x4 va[4], vb[4];
#pragma unroll
        for (int i = 0; i < 4; ++i) va[i] = __builtin_nontemporal_load(spa + i);
#pragma unroll
        for (int i = 0; i < 4; ++i) vb[i] = __builtin_nontemporal_load(spb + i);
        float ama = 0.f, amb = 0.f;
#pragma unroll
        for (int i = 0; i < 4; ++i) {
            if (cgain) { const f32x4 g = ((const f32x4*)(cgain + lane * 16))[i]; va[i] *= g; vb[i] *= g; }
            ama = fmaxf(ama, fmaxf(fmaxf(fabsf(va[i][0]), fabsf(va[i][1])), fmaxf(fabsf(va[i][2]), fabsf(va[i][3]))));
            amb = fmaxf(amb, fmaxf(fmaxf(fabsf(vb[i][0]), fabsf(vb[i][1])), fmaxf(fabsf(vb[i][2]), fabsf(vb[i][3]))));
        }
#pragma unroll
        for (int off = 32; off >= 1; off >>= 1) { ama = fmaxf(ama, __shfl_xor(ama, off)); amb = fmaxf(amb, __shfl_xor(amb, off)); }
        const float inva = ama > 0.f ? 127.0f / ama : 0.f, invb = amb > 0.f ? 127.0f / amb : 0.f;
        u32x4 oa, ob;
#pragma unroll
        for (int i = 0; i < 4; ++i) {
            const int a0 = (int)rintf(va[i][0] * inva), a1 = (int)rintf(va[i][1] * inva), a2 = (int)rintf(va[i][2] * inva), a3 = (int)rintf(va[i][3] * inva);
            oa[i] = (unsigned)(a0 & 255) | ((unsigned)(a1 & 255) << 8) | ((unsigned)(a2 & 255) << 16) | ((unsigned)(a3 & 255) << 24);
            const int b0 = (int)rintf(vb[i][0] * invb), b1 = (int)rintf(vb[i][1] * invb), b2 = (int)rintf(vb[i][2] * invb), b3 = (int)rintf(vb[i][3] * invb);
            ob[i] = (unsigned)(b0 & 255) | ((unsigned)(b1 & 255) << 8) | ((unsigned)(b2 & 255) << 16) | ((unsigned)(b3 & 255) << 24);
        }
        *(u32x4*)(dst + (size_t)row * 1024 + lane * 16) = oa;
        if (lane == 0) scale[row] = ama > 0.f ? ama * (1.0f / 127.0f) : 1.0f;
        if (rowb != row) {
            *(u32x4*)(dst + (size_t)rowb * 1024 + lane * 16) = ob;
            if (lane == 0) scale[rowb] = amb > 0.f ? amb * (1.0f / 127.0f) : 1.0f;
        }
    }
}
DI void copy_shift_part(const float* __restrict__ src, float* __restrict__ dst, int keep, int row4, int bidx, int nblk) {
    const unsigned per_b = (unsigned)(keep - 8) * (unsigned)row4, total = per_b * (unsigned)BD, stride = (unsigned)nblk * NTHREADS;
    for (unsigned i0 = (unsigned)bidx * NTHREADS + (unsigned)otid(); i0 < total; i0 += 4u * stride) {
        f32x4 v[4];
#pragma unroll
        for (int k = 0; k < 4; ++k) {
            const unsigned i = i0 + (unsigned)k * stride;
            if (i < total) { const unsigned b = i / per_b, off = i - b * per_b; v[k] = __builtin_nontemporal_load((const f32x4*)src + ((size_t)b * keep + 8) * row4 + off); }
        }
#pragma unroll
        for (int k = 0; k < 4; ++k) {
            const unsigned i = i0 + (unsigned)k * stride;
            if (i < total) { const unsigned b = i / per_b, off = i - b * per_b; __builtin_nontemporal_store(v[k], (f32x4*)dst + (size_t)b * keep * row4 + off); }
        }
    }
}
DI void copy_shift(const float* __restrict__ src, float* __restrict__ dst, int keep, int row4) {
    const size_t per_b = (size_t)(keep - 8) * row4, total = per_b * BD;
    const size_t stride = (size_t)gridDim.x * NTHREADS;
    for (size_t i = (size_t)blockIdx.x * NTHREADS + otid(); i < total; i += stride) {
        const size_t b = i / per_b, off = i - b * per_b;
        const f32x4 v = __builtin_nontemporal_load((const f32x4*)src + (b * (size_t)keep + 8) * row4 + off);
        __builtin_nontemporal_store(v, (f32x4*)dst + b * (size_t)keep * row4 + off);
    }
}
DI void norm_rows(const float* __restrict__ srcP, const float* __restrict__ srcS, bf16_t* __restrict__ xhat) {
    const int lane = otid() & 63, gw = blockIdx.x * (NTHREADS / 64) + (otid() >> 6), nw = gridDim.x * (NTHREADS / 64);
    for (int row = gw; row < M; row += nw) {
        const float* src = row < MP ? srcP + (size_t)row * D : srcS + (size_t)(row - MP) * D;
        float4 v[4]; float ss = 0.f;
#pragma unroll
        for (int i = 0; i < 4; ++i) { v[i] = ((const float4*)src)[lane + 64 * i]; ss += v[i].x * v[i].x + v[i].y * v[i].y + v[i].z * v[i].z + v[i].w * v[i].w; }
        ss = wave_sum(ss);
        const float rs = rsqrtf(ss * (1.0f / D) + 1e-6f);
#pragma unroll
        for (int i = 0; i < 4; ++i) {
            u32x2 o; o.x = pk2(v[i].x * rs, v[i].y * rs); o.y = pk2(v[i].z * rs, v[i].w * rs);
            ((u32x2*)(xhat + (size_t)row * D))[lane + 64 * i] = o;
        }
    }
}
DI void sincos_d(double r, double& s, double& c) {
    const double r2 = r * r;
    double ts = 1.0, tc = 1.0;
#pragma unroll
    for (int k = 13; k >= 1; --k) { ts = 1.0 - ts * r2 / (double)((2 * k) * (2 * k + 1)); tc = 1.0 - tc * r2 / (double)((2 * k - 1) * (2 * k)); }
    s = r * ts; c = tc;
}

template <int PV> DI void phase_prologue(const Params& p, unsigned char* smem) {
    unsigned char* ws = p.ws;
    float* tile = (float*)smem;
    quant_weight_strips(p.w_in_a, N_IN, ws + W_WTIN, (float*)(ws + W_SWIN), p.g_mix, tile);
    quant_weight_strips(p.w_kv_b, N_KV, ws + W_WTKVQG, (float*)(ws + W_SWKV), p.g_kv, tile);
    quant_weight_strips(p.w_qg_b, 1072, ws + W_WTKVQG + (size_t)N_KV * 1024, (float*)(ws + W_SWKV) + N_KV, p.g_mix + D, tile);
    {
        const size_t gt = (size_t)blockIdx.x * NTHREADS + otid(), gs = (size_t)gridDim.x * NTHREADS;
        unsigned* z = (unsigned*)(ws + W_WTKVQG + (size_t)2608 * 1024);
        for (size_t i = gt; i < (size_t)80 * 1024 / 4; i += gs) z[i] = 0u;
        float* swp = (float*)(ws + W_SWKV);
        for (size_t i = gt; i < 80; i += gs) swp[2608 + i] = 1.0f;
    }
    transpose_cvt(p.w_o_a, 512, 1024, (bf16_t*)(ws + W_WTOA), nullptr, tile);
    quant_weight_strips(p.w_peer_q, N_PQ, ws + W_WTPQ, (float*)(ws + W_SWPQ), p.g_ffn, tile);
    quant_weight_strips(p.w_peer_q + (size_t)1024 * N_PQ, N_PQ, ws + W_WTPQ + (size_t)N_PQ * 1024, (float*)(ws + W_SWPQ) + N_PQ, p.g_ffn + D, tile);
    transpose_cvt(p.w_o_b, 1024, 1024, (bf16_t*)(ws + W_WTOB), nullptr, tile);
    transpose_cvt(p.w_cmp1, 2048, 64, (bf16_t*)(ws + W_WC1), nullptr, tile);
    transpose_cvt(p.w_cmp1 + (size_t)2048 * 64, 2048, 64, (bf16_t*)(ws + W_WC1) + (size_t)64 * 2048, nullptr, tile);
    transpose_cvt(p.w_cmp2, 64, 64, (bf16_t*)(ws + W_WC2), nullptr, tile);
    transpose_cvt(p.w_cmp2 + 4096, 64, 64, (bf16_t*)(ws + W_WC2) + 4096, nullptr, tile);
    const size_t gtid = (size_t)blockIdx.x * NTHREADS + otid(), gstride = (size_t)gridDim.x * NTHREADS;
    {
        bf16_t* dst = (bf16_t*)(ws + W_SUBK);
        for (size_t i = gtid; i < (size_t)2 * 2 * 128 * 128 / 4; i += gstride) {
            const int e = (int)i * 4, d = e & 127, n = (e >> 7) & 127, lz = e >> 14;
            const float4 v = ((const float4*)p.peer_subkeys)[i];
            u32x2 o; o.x = pk2(v.x, v.y); o.y = pk2(v.z, v.w);
            const size_t unit = (size_t)((lz * 8 + (n >> 4)) * 4 + (d >> 5)) * 64 + ((d & 31) >> 3) * 16 + (n & 15);
            *(u32x2*)(dst + unit * 8 + (d & 7)) = o;
        }
    }
    if (PV != 1 && !FLOAT_WORK) {
    quant_rows(p.peer_u, ws + W_U8, (float*)(ws + W_SU), NEXP, 0, p.g_ffn);
    quant_rows(p.peer_u + (size_t)NEXP * 1024, ws + W_U8 + (size_t)NEXP * 1024, (float*)(ws + W_SU) + NEXP, NEXP, 0, p.g_ffn + D);
    quant_rows(p.peer_v, ws + W_V8, (float*)(ws + W_SV), 2 * NEXP, 0);
    }
    {
        float2* tab = (float2*)(ws + W_ROPE);
        for (size_t i = gtid; i < (size_t)8200 * 8; i += gstride) {
            const int pos = (int)(i >> 3), fi = (int)(i & 7);
            const float inv = (float)exp(-log(500000.0) * (double)fi * 0.125);
            const float ang = (float)pos * inv;
            const double a = (double)ang;
            const double k = rint(a * 0.15915494309189535);
            const double r = a - k * 6.283185307179586476925;
            double s, c; sincos_d(r, s, c);
            tab[i] = make_float2((float)c, (float)s);
        }
    }
    {
        const int lane = otid() & 63, gw = blockIdx.x * (NTHREADS / 64) + (otid() >> 6), nw = gridDim.x * (NTHREADS / 64);
        float* pet = (float*)(ws + W_PET);
        for (int o = gw; o < 128; o += nw) {
            const int z = o >> 6, f = o & 63; float s = 0.f;
            for (int k = lane; k < 2048; k += 64) s += p.pe_cmp[z * 2048 + k] * p.w_cmp1[((size_t)z * 2048 + k) * 64 + f];
            s = wave_sum(s);
            if (lane == 0) pet[o] = s;
        }
    }
    norm_rows_q8(p.x_prompt, p.x_sample, ws + W_XQ, (float*)(ws + W_SA));
    if (PV != 2 && !FLOAT_WORK) {
    copy_shift(p.cache_a0, p.out + O_A1S, 128, 256);
    copy_shift(p.cache_a1, p.out + O_A2S, 512, 256);
    copy_shift(p.cache_a2, p.out + O_A3S, 2048, 256);
    copy_shift(p.cache_b_win, p.out + O_BWS, 512, 128);
    }
}

DI void phase_prologue2(const Params& p, unsigned char* smem) {
    unsigned char* ws = p.ws;
    float* tile = (float*)smem;
    transpose_q8(p.w_in_a, 1024, N_IN, ws + W_WTIN, (float*)(ws + W_SWIN), p.g_mix, (const unsigned*)(ws + W_CMIN), tile);
    transpose_q8(p.w_kv_b, 1024, N_KV, ws + W_WTKVQG, (float*)(ws + W_SWKV), p.g_kv, (const unsigned*)(ws + W_CMKV), tile);
    transpose_q8(p.w_qg_b, 1024, 1072, ws + W_WTKVQG + (size_t)N_KV * 1024, (float*)(ws + W_SWKV) + N_KV, p.g_mix + D, (const unsigned*)(ws + W_CMKV) + N_KV, tile);
    const size_t gtid = (size_t)blockIdx.x * NTHREADS + otid(), gstride = (size_t)gridDim.x * NTHREADS;
    {
        unsigned* z = (unsigned*)(ws + W_WTKVQG + (size_t)2608 * 1024);
        for (size_t i = gtid; i < (size_t)80 * 1024 / 4; i += gstride) z[i] = 0u;
        float* sw = (float*)(ws + W_SWKV);
        for (size_t i = gtid; i < 80; i += gstride) sw[2608 + i] = 1.0f;
    }
}

constexpr int C_LD = 132;
DI float dpp_sum16(float v);
DI u32x2 pk4(const f32x4& v) { u32x2 o; o.x = pk2(v[0], v[1]); o.y = pk2(v[2], v[3]); return o; }
DI u32x4 pk8(const float (&v)[8]) { u32x4 o; o.x = pk2(v[0], v[1]); o.y = pk2(v[2], v[3]); o.z = pk2(v[4], v[5]); o.w = pk2(v[6], v[7]); return o; }
DI float row_rs(const Params& p, int which, int row) { return rsqrtf(((const float*)(p.ws + W_ROWSS))[which * M + row] * (1.0f / D) + 1e-6f); }
DI void rope8(const Params& p, int row, int d8, float (&v)[8], const float* partner) {
    const f32x4* tab = (const f32x4*)((const float2*)(p.ws + W_ROPE) + pos_of_row(row) * 8);
    const f32x4 pa = *(const f32x4*)partner, pb = *(const f32x4*)(partner + 4);
    const float pr[8] = {pa[0], pa[1], pa[2], pa[3], pb[0], pb[1], pb[2], pb[3]};
#pragma unroll
    for (int h = 0; h < 4; ++h) {
        const f32x4 t = tab[h];
        v[2 * h] = d8 == 0 ? v[2 * h] * t[0] - pr[2 * h] * t[1] : v[2 * h] * t[0] + pr[2 * h] * t[1];
        v[2 * h + 1] = d8 == 0 ? v[2 * h + 1] * t[2] - pr[2 * h + 1] * t[3] : v[2 * h + 1] * t[2] + pr[2 * h + 1] * t[3];
    }
}
DI void st8f(float* dst, const float (&v)[8]) { *(f32x4*)dst = (f32x4){v[0], v[1], v[2], v[3]}; *(f32x4*)(dst + 4) = (f32x4){v[4], v[5], v[6], v[7]}; }

template <int EPI> DI void epi_chunk(const Params& p, int row, int col8, float (&v)[8], const float* crow, int ch);

template <> DI void epi_chunk<1>(const Params& p, int row, int col8, float (&v)[8], const float* crow, int ch) {
    const int g = col8 / 1536, rem = col8 - g * 1536, cc = rem >> 9, head = (rem >> 6) & 7, d8 = rem & 63;
    if (cc < 2 && d8 < 16) rope8(p, row, d8, v, crow + ((ch ^ 1) << 3));
    if (cc == 0) {
#pragma unroll
        for (int i = 0; i < 8; ++i) v[i] *= QSCALE;
        *(u32x4*)((bf16_t*)(p.ws + W_QA) + (size_t)row * 1536 + g * 512 + head * 64 + d8) = pk8(v);
        return;
    }
    const int kv = cc - 1, lg = 2 * g, win = 128 << lg;
    const size_t oP = g == 0 ? O_A1P : (g == 1 ? O_A2P : O_A3P), oS = g == 0 ? O_A1S : (g == 1 ? O_A2S : O_A3S);
    if (row < MP) {
        const int b = row >> 13, L = SEQ >> lg, t = row & (SEQ - 1);
        if (kv == 0) {
            const int pp = (t & ((1 << lg) - 1)) * L + (t >> lg);
            bf16_t* KA = (bf16_t*)(p.ws + W_KA) + (size_t)((g * 2 + b) * 8 + head) * SEQ * 64;
            const int unit = ((pp >> 4) * 2 + (d8 >> 5)) * 64 + ((d8 & 31) >> 3) * 16 + (pp & 15);
            *(u32x4*)(KA + (size_t)unit * 8) = pk8(v);
        }
        if (t >= SEQ - win) st8f(p.out + oP + ((size_t)(b * win + t - (SEQ - win)) * 2 + kv) * 512 + head * 64 + d8, v);
    } else {
        const int r = row - MP, bd = r >> 3, sidx = r & 7;
        st8f(p.out + oS + ((size_t)(bd * win + win - 8 + sidx) * 2 + kv) * 512 + head * 64 + d8, v);
    }
}
DI void epi_resid(const Params& p, int which, int row, int col8, float (&v)[8], const float* xin) {
    const f32x4 a = *(const f32x4*)xin, b2 = *(const f32x4*)(xin + 4);
    v[0] += a[0]; v[1] += a[1]; v[2] += a[2]; v[3] += a[3]; v[4] += b2[0]; v[5] += b2[1]; v[6] += b2[2]; v[7] += b2[3];
    st8f((float*)(p.ws + W_XR) + (size_t)row * D + col8, v);
}
template <> DI void epi_chunk<3>(const Params& p, int row, int col8, float (&v)[8], const float* crow, int ch) {
    epi_resid(p, 0, row, col8, v, row < MP ? p.x_prompt + (size_t)row * D + col8 : p.x_sample + (size_t)(row - MP) * D + col8);
}
template <> DI void epi_chunk<11>(const Params& p, int row, int col8, float (&v)[8], const float* crow, int ch) {
    epi_resid(p, 1, row, col8, v, (const float*)(p.ws + W_XR) + (size_t)row * D + col8);
}
DI void epi_qh(const Params& p, int which, int row, int col8, float (&v)[8]) {
    *(u32x4*)((bf16_t*)(p.ws + W_QH) + ((size_t)((row >> 4) * 64 + (col8 >> 5)) * 64 + ((col8 & 31) >> 3) * 16 + (row & 15)) * 8) = pk8(v);
}
template <> DI void epi_chunk<5>(const Params& p, int row, int col8, float (&v)[8], const float* crow, int ch) { epi_qh(p, 0, row, col8, v); }
template <> DI void epi_chunk<6>(const Params& p, int row, int col8, float (&v)[8], const float* crow, int ch) { epi_qh(p, 1, row, col8, v); }
template <> DI void epi_chunk<8>(const Params& p, int row, int col8, float (&v)[8], const float* crow, int ch) {
    unsigned char* ws = p.ws;
    if (col8 < N_KV) {
        const int cc = col8 >> 8, kvh = (col8 >> 6) & 3, d8 = col8 & 63;
        if ((cc == 2 || cc == 4) && d8 < 16) rope8(p, row, d8, v, crow + ((ch ^ 1) << 3));
        if (row < MP) {
            const int b = row >> 13, t = row & (SEQ - 1);
            if (cc < 4) st8f(p.out + O_BKVP + (size_t)row * 1024 + col8, v);
            else if (t >= SEQ - 512) st8f(p.out + O_BWP + ((size_t)(b * 512 + t - (SEQ - 512)) * 2 + (cc - 4)) * 256 + kvh * 64 + d8, v);
            if (cc == 0 || cc == 1) *(u32x4*)((bf16_t*)(ws + (cc == 0 ? W_CMPK : W_CMPV)) + ((size_t)row * 4 + kvh) * 64 + d8) = pk8(v);
            else if (cc == 2 || cc == 4) *(u32x4*)((bf16_t*)(ws + (cc == 2 ? W_SELK : W_WINK)) + ((size_t)(b * 4 + kvh) * SEQ + t) * 64 + d8) = pk8(v);
        } else {
            const int r = row - MP, bd = r >> 3, sidx = r & 7;
            if (cc < 4) st8f(p.out + O_BKVS + (size_t)r * 1024 + col8, v);
            else st8f(p.out + O_BWS + ((size_t)(bd * 512 + 504 + sidx) * 2 + (cc - 4)) * 256 + kvh * 64 + d8, v);
        }
    } else if (col8 < N_KV + 1024) {
        const int qc = col8 - N_KV;
        if ((qc & 63) < 16) rope8(p, row, qc & 63, v, crow + ((ch ^ 1) << 3));
#pragma unroll
        for (int i = 0; i < 8; ++i) v[i] *= QSCALE;
        *(u32x4*)((bf16_t*)(ws + W_QB) + (size_t)row * 1024 + qc) = pk8(v);
    } else if (col8 < N_KV + 1072) {
        const int gc = col8 - N_KV - 1024;
        const f32x4 ba = *(const f32x4*)(p.b_gate_b + gc), bb2 = *(const f32x4*)(p.b_gate_b + gc + 4);
        const float bias[8] = {ba[0], ba[1], ba[2], ba[3], bb2[0], bb2[1], bb2[2], bb2[3]};
#pragma unroll
        for (int i = 0; i < 8; ++i) v[i] = 1.0f / (1.0f + __expf(-(v[i] + bias[i])));
        st8f((float*)(ws + W_GATE) + (size_t)row * 48 + gc, v);
    }
}

template <int EPI> DI void epi_vcols(const Params& p, int tm, int tn, const float* Cs, int tid) {
    const int row0 = tm * 128, colb = tn * 128;
    if (row0 >= MP) return;
    const int b = row0 >> 13, t0 = row0 & (SEQ - 1);
    if (EPI == 1) {
        const int g = colb / 1536, rem = colb - g * 1536, cc = rem >> 9;
        if (cc != 2) return;
        const int lg = 2 * g, dil = 1 << lg, L = SEQ >> lg, head0 = (rem >> 6) & 7;
#pragma unroll 4
        for (int k = 0; k < 16; ++k) {
            const int id = tid + 256 * k, col = id & 127, qd = id >> 7;
            const int res = qd & (dil - 1), mq = qd >> lg;
            const int head = head0 + (col >> 6), d = col & 63;
            const int pp0 = res * L + (t0 >> lg) + 4 * mq;
            float x[4];
#pragma unroll
            for (int e = 0; e < 4; ++e) x[e] = Cs[(res + dil * (4 * mq + e)) * C_LD + col];
            bf16_t* VAT = (bf16_t*)(p.ws + W_VAT) + (size_t)((g * 2 + b) * 8 + head) * 64 * SEQ;
            const int unit = ((pp0 >> 5) * 4 + (d >> 4)) * 64 + ((pp0 & 15) >> 2) * 16 + (d & 15);
            u32x2 w; w.x = pk2(x[0], x[1]); w.y = pk2(x[2], x[3]);
            *(u32x2*)(VAT + (size_t)unit * 8 + 4 * ((pp0 >> 4) & 1)) = w;
        }
    } else {
        if (colb >= N_KV) return;
        const int cc = colb >> 8;
        if (cc != 3 && cc != 5) return;
        const int kvh0 = (colb >> 6) & 3;
#pragma unroll 4
        for (int k = 0; k < 8; ++k) {
            const int id = tid + 256 * k, col = id & 127, rg = id >> 7;
            const int kvh = kvh0 + (col >> 6), d = col & 63;
            float x[8];
#pragma unroll
            for (int e = 0; e < 8; ++e) x[e] = Cs[(rg * 8 + e) * C_LD + col];
            bf16_t* dst = (bf16_t*)(p.ws + (cc == 3 ? W_SELVT : W_WINVT)) + ((size_t)(b * 4 + kvh) * 64 + d) * SEQ + t0 + rg * 8;
            *(u32x4*)dst = pk8(x);
        }
    }
}
template <int EPI> DI void epilogue_tile(const Params& p, int tm, int tn, const float* Cs, int tid) {
#pragma unroll 2
    for (int k = 0; k < 8; ++k) {
        const int id = tid + 256 * k, r = id >> 4, ch = id & 15;
        const float* crow = Cs + r * C_LD;
        const f32x4 a = *(const f32x4*)(crow + ch * 8), b2 = *(const f32x4*)(crow + ch * 8 + 4);
        float v[8] = {a[0], a[1], a[2], a[3], b2[0], b2[1], b2[2], b2[3]};
        epi_chunk<EPI>(p, tm * 128 + r, tn * 128 + ch * 8, v, crow, ch);
    }
    if (EPI == 1 || EPI == 8) epi_vcols<EPI>(p, tm, tn, Cs, tid);
}

constexpr int G_LD = 72;
constexpr int G_TILE = 128 * G_LD;
struct GRegs { bf16x8 a[4], b[4]; };
template <int EPI> DI void gemm_run(const Params& p, const bf16_t* __restrict__ A, const bf16_t* __restrict__ Bt, int K, int ntn, unsigned char* smem) {
    bf16_t* As = (bf16_t*)smem;
    bf16_t* Bs = As + 2 * G_TILE;
    const int tid = otid(), lane = tid & 63, w = tid >> 6, wm = w >> 1, wn = w & 1, c = lane & 15, Q = lane >> 4;
    const int lr = tid >> 3, lk = (tid & 7) * 8;
    const int ntiles = (M / 128) * ntn, nk = K >> 6;
    const int voff = lr * K + lk;
    GRegs R0, R1;
    const bf16_t* Ag = A;
    const bf16_t* Bg = Bt;
#define G_LOAD(R, kt) { _Pragma("unroll") for (int i_ = 0; i_ < 4; ++i_) { \
            R.a[i_] = *(const bf16x8*)(Ag + (voff + (32 * i_ * K + (kt) * 64))); R.b[i_] = *(const bf16x8*)(Bg + (voff + (32 * i_ * K + (kt) * 64))); } }
#define G_STORE(R, buf) { _Pragma("unroll") for (int i_ = 0; i_ < 4; ++i_) { \
            *(bf16x8*)&As[(buf) * G_TILE + (lr + 32 * i_) * G_LD + lk] = R.a[i_]; *(bf16x8*)&Bs[(buf) * G_TILE + (lr + 32 * i_) * G_LD + lk] = R.b[i_]; } }
#define G_COMPUTE(buf) { _Pragma("unroll") for (int ks_ = 0; ks_ < 2; ++ks_) { bf16x8 af[4], bfr[4]; \
            _Pragma("unroll") for (int i_ = 0; i_ < 4; ++i_) { \
                af[i_] = *(const bf16x8*)&As[(buf) * G_TILE + (wm * 64 + i_ * 16 + c) * G_LD + ks_ * 32 + Q * 8]; \
                bfr[i_] = *(const bf16x8*)&Bs[(buf) * G_TILE + (wn * 64 + i_ * 16 + c) * G_LD + ks_ * 32 + Q * 8]; } \
            __builtin_amdgcn_s_setprio(1); \
            _Pragma("unroll") for (int i_ = 0; i_ < 4; ++i_) _Pragma("unroll") for (int j_ = 0; j_ < 4; ++j_) acc[i_][j_] = MFMA16(bfr[j_], af[i_], acc[i_][j_]); \
            __builtin_amdgcn_s_setprio(0); } }
#define G_STEP(KT, Ra, Rb) { const int kt_ = (KT); if (kt_ + 2 < nk) G_LOAD(Ra, kt_ + 2); G_COMPUTE(kt_ & 1); if (kt_ + 1 < nk) G_STORE(Rb, (kt_ + 1) & 1); lds_barrier(); }
    int tile = blockIdx.x;
    if (tile < ntiles) {
        const int tm0 = tile / ntn, tn0 = tile - tm0 * ntn;
        Ag = A + (size_t)(tm0 * 128) * K; Bg = Bt + (size_t)(tn0 * 128) * K;
        G_LOAD(R0, 0); G_LOAD(R1, 1);
    }
    while (tile < ntiles) {
        const int tm = tile / ntn, tn = tile - tm * ntn;
        f32x4 acc[4][4];
#pragma unroll
        for (int i = 0; i < 4; ++i)
#pragma unroll
            for (int j = 0; j < 4; ++j) acc[i][j] = (f32x4){0.f, 0.f, 0.f, 0.f};
        G_STORE(R0, 0);
        lds_barrier();
        for (int kt = 0; kt < nk; kt += 2) { G_STEP(kt, R0, R1); G_STEP(kt + 1, R1, R0); }
        {
            float* Cs = (float*)smem;
#pragma unroll
            for (int i = 0; i < 4; ++i)
#pragma unroll
                for (int j = 0; j < 4; ++j) *(f32x4*)&Cs[(wm * 64 + i * 16 + c) * C_LD + wn * 64 + j * 16 + 4 * Q] = acc[i][j];
            const int ntile = tile + (int)gridDim.x;
            if (ntile < ntiles) {
                const int tmn = ntile / ntn, tnn = ntile - tmn * ntn;
                Ag = A + (size_t)(tmn * 128) * K; Bg = Bt + (size_t)(tnn * 128) * K;
                G_LOAD(R0, 0); G_LOAD(R1, 1);
            }
            lds_barrier();
            epilogue_tile<EPI>(p, tm, tn, Cs, tid);
            lds_barrier();
            tile = ntile;
        }
    }
#undef G_LOAD
#undef G_STORE
#undef G_COMPUTE
#undef G_STEP
}

constexpr int Q_LD = 144;
constexpr int Q_TILE = 128 * Q_LD;
struct QRegs { i32x4 a[4], b[4]; };
template <int EPI> DI void gemm_run_i8(const Params& p, const unsigned char* __restrict__ A, const float* __restrict__ sa,
                                       const unsigned char* __restrict__ Bt, const float* __restrict__ sw, int ntn, unsigned char* smem) {
    constexpr int K = 1024, nk = K / 128;
    unsigned char* As = smem;
    unsigned char* Bs = smem + 2 * Q_TILE;
    const int tid = otid(), lane = tid & 63, w = tid >> 6, wm = w >> 1, wn = w & 1, c = lane & 15, Q = lane >> 4;
    const int lr = tid >> 3, lk = (tid & 7) * 16;
    const int ntiles = (M / 128) * ntn;
    const int voff = lr * K + lk;
    QRegs R0, R1;
    const unsigned char* Ag = A;
    const unsigned char* Bg = Bt;
#define Q_LOAD(R, kt) { _Pragma("unroll") for (int i_ = 0; i_ < 4; ++i_) { \
            R.a[i_] = *(const i32x4*)(Ag + (voff + (32 * i_ * K + (kt) * 128))); R.b[i_] = *(const i32x4*)(Bg + (voff + (32 * i_ * K + (kt) * 128))); } }
#define Q_STORE(R, buf) { _Pragma("unroll") for (int i_ = 0; i_ < 4; ++i_) { \
            *(i32x4*)&As[(buf) * Q_TILE + (lr + 32 * i_) * Q_LD + lk] = R.a[i_]; *(i32x4*)&Bs[(buf) * Q_TILE + (lr + 32 * i_) * Q_LD + lk] = R.b[i_]; } }
#define Q_COMPUTE(buf) { _Pragma("unroll") for (int ks_ = 0; ks_ < 2; ++ks_) { i32x4 af[4], bfr[4]; \
            _Pragma("unroll") for (int i_ = 0; i_ < 4; ++i_) { \
                af[i_] = *(const i32x4*)&As[(buf) * Q_TILE + (wm * 64 + i_ * 16 + c) * Q_LD + ks_ * 64 + Q * 16]; \
                bfr[i_] = *(const i32x4*)&Bs[(buf) * Q_TILE + (wn * 64 + i_ * 16 + c) * Q_LD + ks_ * 64 + Q * 16]; } \
            __builtin_amdgcn_s_setprio(1); \
            _Pragma("unroll") for (int i_ = 0; i_ < 4; ++i_) _Pragma("unroll") for (int j_ = 0; j_ < 4; ++j_) acc[i_][j_] = MFMA_I8(bfr[j_], af[i_], acc[i_][j_]); \
            __builtin_amdgcn_s_setprio(0); } }
#define Q_STEP(KT, Ra, Rb) { const int kt_ = (KT); if (kt_ + 2 < nk) Q_LOAD(Ra, kt_ + 2); Q_COMPUTE(kt_ & 1); if (kt_ + 1 < nk) Q_STORE(Rb, (kt_ + 1) & 1); lds_barrier(); }
    int tile = blockIdx.x;
    if (tile < ntiles) {
        const int tm0 = tile / ntn, tn0 = tile - tm0 * ntn;
        Ag = A + (size_t)(tm0 * 128) * K; Bg = Bt + (size_t)(tn0 * 128) * K;
        Q_LOAD(R0, 0); Q_LOAD(R1, 1);
    }
    while (tile < ntiles) {
        const int tm = tile / ntn, tn = tile - tm * ntn;
        i32x4 acc[4][4];
#pragma unroll
        for (int i = 0; i < 4; ++i)
#pragma unroll
            for (int j = 0; j < 4; ++j) acc[i][j] = (i32x4){0, 0, 0, 0};
        Q_STORE(R0, 0);
        lds_barrier();
#pragma unroll 1
        for (int kt = 0; kt < nk; kt += 2) { Q_STEP(kt, R0, R1); Q_STEP(kt + 1, R1, R0); }
        {
            float* Cs = (float*)smem;
#pragma unroll
            for (int i = 0; i < 4; ++i) {
                const float sr = sa[tm * 128 + wm * 64 + i * 16 + c];
#pragma unroll
                for (int j = 0; j < 4; ++j) {
                    const f32x4 sc = *(const f32x4*)(sw + tn * 128 + wn * 64 + j * 16 + 4 * Q);
                    f32x4 v;
#pragma unroll
                    for (int r = 0; r < 4; ++r) v[r] = (float)acc[i][j][r] * (sr * sc[r]);
                    *(f32x4*)&Cs[(wm * 64 + i * 16 + c) * C_LD + wn * 64 + j * 16 + 4 * Q] = v;
                }
            }
            const int ntile = tile + (int)gridDim.x;
            if (ntile < ntiles) {
                const int tmn = ntile / ntn, tnn = ntile - tmn * ntn;
                Ag = A + (size_t)(tmn * 128) * K; Bg = Bt + (size_t)(tnn * 128) * K;
                Q_LOAD(R0, 0); Q_LOAD(R1, 1);
            }
            lds_barrier();
            epilogue_tile<EPI>(p, tm, tn, Cs, tid);
            lds_barrier();
            tile = ntile;
        }
    }
#undef Q_LOAD
#undef Q_STORE
#undef Q_COMPUTE
#undef Q_STEP
}

struct KVbf {
    const bf16_t* K; const bf16_t* VT; int ldv; int Q;
    DI bf16x8 kfrag(int key, int ks) const { return *(const bf16x8*)(K + (size_t)key * 64 + ks * 32 + Q * 8); }
    DI bf16x8 vfrag(int d, int key0) const {
        const bf16x4 lo = *(const bf16x4*)(VT + (size_t)d * ldv + key0 + 4 * Q);
        const bf16x4 hi = *(const bf16x4*)(VT + (size_t)d * ldv + key0 + 16 + 4 * Q);
        return __builtin_shufflevector(lo, hi, 0, 1, 2, 3, 4, 5, 6, 7);
    }
};
struct KVtiled {
    const bf16_t* K; const bf16_t* VT; int lane;
    DI bf16x8 kfrag(int key, int ks) const { return *(const bf16x8*)(K + ((size_t)((key >> 4) * 2 + ks) * 64 + lane) * 8); }
    DI bf16x8 vfrag(int d, int key0) const { return *(const bf16x8*)(VT + ((size_t)((key0 >> 5) * 4 + (d >> 4)) * 64 + lane) * 8); }
};
template <class RowF> struct KVf32 {
    RowF rf; int Q;
    DI bf16x8 kfrag(int key, int ks) const {
        const float* r = rf(key, 0) + ks * 32 + Q * 8;
        const float4 a = *(const float4*)r, b = *(const float4*)(r + 4);
        return pack8(a.x, a.y, a.z, a.w, b.x, b.y, b.z, b.w);
    }
    DI bf16x8 vfrag(int d, int key0) const {
        float v[8];
#pragma unroll
        for (int j = 0; j < 4; ++j) { v[j] = rf(key0 + 4 * Q + j, 1)[d]; v[4 + j] = rf(key0 + 16 + 4 * Q + j, 1)[d]; }
        return pack8(v[0], v[1], v[2], v[3], v[4], v[5], v[6], v[7]);
    }
};

constexpr float LAZY_T = 8.0f;
DI float row_sum(float l) { l += __shfl_xor(l, 16); l += __shfl_xor(l, 32); return l; }
template <class KV, class MaskF>
DI void attn_tile(const bf16x8& q0, const bf16x8& q1, const KV& kv, int key0, MaskF&& maskf, float& m, float& l, f32x4 (&o)[4], int c, int Q) {
    f32x4 s0 = {0.f, 0.f, 0.f, 0.f}, s1 = {0.f, 0.f, 0.f, 0.f};
    s0 = MFMA16(kv.kfrag(key0 + c, 0), q0, s0);
    s0 = MFMA16(kv.kfrag(key0 + c, 1), q1, s0);
    s1 = MFMA16(kv.kfrag(key0 + 16 + c, 0), q0, s1);
    s1 = MFMA16(kv.kfrag(key0 + 16 + c, 1), q1, s1);
    float mx = NEG_INF;
#pragma unroll
    for (int j = 0; j < 4; ++j) {
        if (!maskf(key0 + 4 * Q + j)) s0[j] = NEG_INF;
        if (!maskf(key0 + 16 + 4 * Q + j)) s1[j] = NEG_INF;
        mx = fmaxf(mx, fmaxf(s0[j], s1[j]));
    }
    if (__any(mx > m + LAZY_T)) {
        mx = fmaxf(mx, __shfl_xor(mx, 16)); mx = fmaxf(mx, __shfl_xor(mx, 32));
        const float mn = fmaxf(m, mx);
        const float alpha = fexp2(m - ((mn == NEG_INF) ? 0.f : mn));
        l *= alpha; m = mn;
#pragma unroll
        for (int db = 0; db < 4; ++db) o[db] = o[db] * alpha;
    }
    const float mu = (m == NEG_INF) ? 0.f : m;
    float p[8];
#pragma unroll
    for (int j = 0; j < 4; ++j) { p[j] = fexp2(s0[j] - mu); p[4 + j] = fexp2(s1[j] - mu); l += p[j] + p[4 + j]; }
    const bf16x8 pb = pack8(p[0], p[1], p[2], p[3], p[4], p[5], p[6], p[7]);
#pragma unroll
    for (int db = 0; db < 4; ++db) o[db] = MFMA16(kv.vfrag(db * 16 + c, key0), pb, o[db]);
}

struct KVregs {
    bf16x8 k[4], v[4];
    DI void load(const KVtiled& t, int key0) {
        k[0] = t.kfrag(key0, 0); k[1] = t.kfrag(key0, 1); k[2] = t.kfrag(key0 + 16, 0); k[3] = t.kfrag(key0 + 16, 1);
#pragma unroll
        for (int db = 0; db < 4; ++db) v[db] = t.vfrag(db * 16, key0);
    }
};
template <class MaskF>
DI void attn_tile_regs(const bf16x8& q0, const bf16x8& q1, const KVregs& F, int key0, MaskF&& maskf, float& m, float& l, f32x4 (&o)[4], int c, int Q) {
    f32x4 s0 = {0.f, 0.f, 0.f, 0.f}, s1 = {0.f, 0.f, 0.f, 0.f};
    s0 = MFMA16(F.k[0], q0, s0); s0 = MFMA16(F.k[1], q1, s0);
    s1 = MFMA16(F.k[2], q0, s1); s1 = MFMA16(F.k[3], q1, s1);
    float mx = NEG_INF;
#pragma unroll
    for (int j = 0; j < 4; ++j) {
        if (!maskf(key0 + 4 * Q + j)) s0[j] = NEG_INF;
        if (!maskf(key0 + 16 + 4 * Q + j)) s1[j] = NEG_INF;
        mx = fmaxf(mx, fmaxf(s0[j], s1[j]));
    }
    if (__any(mx > m + LAZY_T)) {
        mx = fmaxf(mx, __shfl_xor(mx, 16)); mx = fmaxf(mx, __shfl_xor(mx, 32));
        const float mn = fmaxf(m, mx);
        const float alpha = fexp2(m - ((mn == NEG_INF) ? 0.f : mn));
        l *= alpha; m = mn;
#pragma unroll
        for (int db = 0; db < 4; ++db) o[db] = o[db] * alpha;
    }
    const float mu = (m == NEG_INF) ? 0.f : m;
    float p[8];
#pragma unroll
    for (int j = 0; j < 4; ++j) { p[j] = fexp2(s0[j] - mu); p[4 + j] = fexp2(s1[j] - mu); l += p[j] + p[4 + j]; }
    const bf16x8 pb = pack8(p[0], p[1], p[2], p[3], p[4], p[5], p[6], p[7]);
    o[0] = MFMA16(F.v[0], pb, o[0]); o[1] = MFMA16(F.v[1], pb, o[1]); o[2] = MFMA16(F.v[2], pb, o[2]); o[3] = MFMA16(F.v[3], pb, o[3]);
}

DI void attnA_prompt_unit(const Params& p, int u, int lane) {
    const int c = lane & 15, Q = lane >> 4;
    const int r = u & 15, tb = (u >> 4) & 31, head = (u >> 9) & 7, b = u >> 12;
    const int trow = b * SEQ + tb * 256 + r + 16 * c;
    const bf16_t* QA = (const bf16_t*)(p.ws + W_QA) + (size_t)trow * 1536 + head * 64 + Q * 8;
    float m = NEG_INF, l = 0.f; f32x4 o[4];
#pragma unroll
    for (int i = 0; i < 4; ++i) o[i] = (f32x4){0.f, 0.f, 0.f, 0.f};
#pragma unroll
    for (int g = 0; g < 3; ++g) {
        const int lg = 2 * g, L = SEQ >> lg, step = 16 >> lg;
        const int res = r & ((1 << lg) - 1), mq0 = (tb * 256 + r) >> lg, mi = mq0 + step * c;
        const bf16x8 q0 = *(const bf16x8*)(QA + g * 512), q1 = *(const bf16x8*)(QA + g * 512 + 32);
        KVtiled kv;
        kv.K = (const bf16_t*)(p.ws + W_KA) + ((size_t)((g * 2 + b) * 8 + head) * SEQ + (size_t)res * L) * 64;
        kv.VT = (const bf16_t*)(p.ws + W_VAT) + ((size_t)((g * 2 + b) * 8 + head) * SEQ + (size_t)res * L) * 64;
        kv.lane = lane;
        int klo = mq0 - 128; klo = klo < 0 ? 0 : klo; klo &= ~31;
        const int khi = mq0 + 15 * step;
        KVregs F0, F1;
        F0.load(kv, klo);
        for (int key0 = klo; key0 <= khi; key0 += 64) {
            const bool has1 = key0 + 32 <= khi;
            if (has1) F1.load(kv, key0 + 32);
            attn_tile_regs(q0, q1, F0, key0, [&](int k) { return k <= mi && k >= mi - 128; }, m, l, o, c, Q);
            if (has1) {
                if (key0 + 64 <= khi) F0.load(kv, key0 + 64);
                attn_tile_regs(q0, q1, F1, key0 + 32, [&](int k) { return k <= mi && k >= mi - 128; }, m, l, o, c, Q);
            }
        }
    }
    const float inv = 1.0f / row_sum(l);
    bf16_t* OA = (bf16_t*)(p.ws + W_OA) + (size_t)trow * 512 + head * 64;
#pragma unroll
    for (int db = 0; db < 4; ++db) {
        u32x2 w; w.x = pk2(o[db][0] * inv, o[db][1] * inv); w.y = pk2(o[db][2] * inv, o[db][3] * inv);
        *(u32x2*)(OA + db * 16 + 4 * Q) = w;
    }
}
DI void attnA_sample_block(const Params& p, int u, unsigned char* smem, int tid) {
    const int lane = tid & 63, wid = tid >> 6, c = lane & 15, Q = lane >> 4;
    const int head = u & 7, bd = u >> 3;
    const int s = c & 7;
    const bool rowok = c < 8;
    const int trow = MP + bd * 8 + s;
    const bf16_t* QA = (const bf16_t*)(p.ws + W_QA) + (size_t)trow * 1536 + head * 64 + Q * 8;
    float m = NEG_INF, l = 0.f; f32x4 o[4];
#pragma unroll
    for (int i = 0; i < 4; ++i) o[i] = (f32x4){0.f, 0.f, 0.f, 0.f};
    const bf16x8 qa0 = *(const bf16x8*)(QA), qb0 = *(const bf16x8*)(QA + 32);
    const bf16x8 qa1 = *(const bf16x8*)(QA + 512), qb1 = *(const bf16x8*)(QA + 512 + 32);
    const bf16x8 qa2 = *(const bf16x8*)(QA + 1024), qb2 = *(const bf16x8*)(QA + 1024 + 32);
    auto rf0 = [&](int idx, int which) -> const float* {
        idx = idx > 128 + 7 ? 128 + 7 : idx;
        return idx < 128 ? p.cache_a0 + ((size_t)(bd * 128 + idx) * 2 + which) * 512 + head * 64
                         : p.out + O_A1S + ((size_t)(bd * 128 + idx - 8) * 2 + which) * 512 + head * 64;
    };
    auto rf1 = [&](int idx, int which) -> const float* {
        idx = idx > 512 + 7 ? 512 + 7 : idx;
        return idx < 512 ? p.cache_a1 + ((size_t)(bd * 512 + idx) * 2 + which) * 512 + head * 64
                         : p.out + O_A2S + ((size_t)(bd * 512 + idx - 8) * 2 + which) * 512 + head * 64;
    };
    auto rf2 = [&](int kk, int which) -> const float* {
        int j = kk >> 3; j = j > 128 ? 128 : j;
        const int idx = 2048 + (kk & 7) - 16 * j;
        return idx < 2048 ? p.cache_a2 + ((size_t)(bd * 2048 + idx) * 2 + which) * 512 + head * 64
                          : p.out + O_A3S + ((size_t)(bd * 2048 + idx - 8) * 2 + which) * 512 + head * 64;
    };
    KVf32<decltype(rf0)> kv0{rf0, Q};
    KVf32<decltype(rf1)> kv1{rf1, Q};
    KVf32<decltype(rf2)> kv2{rf2, Q};
#pragma unroll 1
    for (int i = wid; i < 55; i += 4) {
        if (i < 5) {
            attn_tile(qa0, qb0, kv0, 32 * i, [&](int k) { const int rel = 128 + s - k; return rowok && rel >= 0 && rel <= 128; }, m, l, o, c, Q);
        } else if (i < 22) {
            attn_tile(qa1, qb1, kv1, 32 * (i - 5), [&](int k) { const int rel = 512 + s - k; return rowok && rel >= 0 && rel <= 512 && (rel & 3) == 0; }, m, l, o, c, Q);
        } else {
            attn_tile(qa2, qb2, kv2, 32 * (i - 22), [&](int k) { return rowok && (k & 7) == s && (k >> 3) <= 128; }, m, l, o, c, Q);
        }
    }
    const float ls = row_sum(l);
    float* mb = (float*)smem + wid * (16 * 66);
    if (Q == 0) { mb[c * 66] = m; mb[c * 66 + 1] = ls; }
#pragma unroll
    for (int db = 0; db < 4; ++db)
#pragma unroll
        for (int j = 0; j < 4; ++j) mb[c * 66 + 2 + db * 16 + 4 * Q + j] = o[db][j];
    __syncthreads();
    if (wid == 0) {
        const float* m0 = (const float*)smem;
        float mw[4], Mx = NEG_INF;
#pragma unroll
        for (int w = 0; w < 4; ++w) { mw[w] = m0[w * (16 * 66) + c * 66]; Mx = fmaxf(Mx, mw[w]); }
        const float Mu = (Mx == NEG_INF) ? 0.f : Mx;
        float L = 0.f, sc[4];
#pragma unroll
        for (int w = 0; w < 4; ++w) { sc[w] = fexp2(mw[w] - Mu); L += m0[w * (16 * 66) + c * 66 + 1] * sc[w]; }
        if (rowok) {
            const float inv = 1.0f / L;
            bf16_t* OA = (bf16_t*)(p.ws + W_OA) + (size_t)trow * 512 + head * 64;
#pragma unroll
            for (int db = 0; db < 4; ++db) {
                float v[4];
#pragma unroll
                for (int j = 0; j < 4; ++j) {
                    float acc = 0.f;
#pragma unroll
                    for (int w = 0; w < 4; ++w) acc += m0[w * (16 * 66) + c * 66 + 2 + db * 16 + 4 * Q + j] * sc[w];
                    v[j] = acc * inv;
                }
                u32x2 wv; wv.x = pk2(v[0], v[1]); wv.y = pk2(v[2], v[3]);
                *(u32x2*)(OA + db * 16 + 4 * Q) = wv;
            }
        }
    }
    __syncthreads();
}
template <int REP> DI void phase_attnA(const Params& p, unsigned char* smem) {
    const int tid = otid(), lane = tid & 63;
    {
        unsigned* cnts = (unsigned*)(p.ws + W_CTL) + CTL_CNT_WORD + 64 * (7 + 8 * REP);
        int* sh_unit = (int*)(smem + 4 * 16 * 66 * 4);
        for (;;) {
            if (tid == 0) *sh_unit = (int)__hip_atomic_fetch_add(cnts, 1u, __ATOMIC_RELAXED, __HIP_MEMORY_SCOPE_AGENT);
            __syncthreads();
            const int u = __builtin_amdgcn_readfirstlane(*sh_unit);
            __syncthreads();
            if (u >= BD * 8) break;
            if (!(REP && PROBE_NSA_ONLY == 2)) attnA_sample_block(p, u, smem, tid);
        }
    }
    unsigned* cnt = (unsigned*)(p.ws + W_CTL) + CTL_CNT_WORD + 64 * (0 + 8 * REP);
    const int NPU = NBP * 8 * 32 * 16;
    for (;;) {
        const int u = wave_next(cnt, lane);
        if (u >= NPU) break;
        if (REP && PROBE_NSA_ONLY == 1) break;
        attnA_prompt_unit(p, u, lane);
    }
}

DI void top16_128(float (&v)[8], int c, float& outv, int& outi) {
    outv = NEG_INF; outi = 0;
    for (int it = 0; it < 16; ++it) {
        float bv = v[0]; int bi = c;
#pragma unroll
        for (int i = 1; i < 8; ++i) if (v[i] > bv) { bv = v[i]; bi = i * 16 + c; }
#pragma unroll
        for (int off = 1; off < 16; off <<= 1) {
            const float ov = __shfl_xor(bv, off); const int oi = __shfl_xor(bi, off);
            if (ov > bv || (ov == bv && oi < bi)) { bv = ov; bi = oi; }
        }
        if (c == it) { outv = bv; outi = bi; }
#pragma unroll
        for (int i = 0; i < 8; ++i) if (bi == i * 16 + c) v[i] = NEG_INF;
    }
}
DI unsigned umax(unsigned a, unsigned b) { return a > b ? a : b; }
DI unsigned dpp_max16(unsigned v) {
    v = umax(v, (unsigned)__builtin_amdgcn_update_dpp(0, (int)v, 0x121, 0xf, 0xf, true));
    v = umax(v, (unsigned)__builtin_amdgcn_update_dpp(0, (int)v, 0x122, 0xf, 0xf, true));
    v = umax(v, (unsigned)__builtin_amdgcn_update_dpp(0, (int)v, 0x124, 0xf, 0xf, true));
    v = umax(v, (unsigned)__builtin_amdgcn_update_dpp(0, (int)v, 0x128, 0xf, 0xf, true));
    return v;
}
DI float dpp_sum16(float v) {
    v += __builtin_bit_cast(float, __builtin_amdgcn_update_dpp(0, __builtin_bit_cast(int, v), 0x121, 0xf, 0xf, true));
    v += __builtin_bit_cast(float, __builtin_amdgcn_update_dpp(0, __builtin_bit_cast(int, v), 0x122, 0xf, 0xf, true));
    v += __builtin_bit_cast(float, __builtin_amdgcn_update_dpp(0, __builtin_bit_cast(int, v), 0x124, 0xf, 0xf, true));
    v += __builtin_bit_cast(float, __builtin_amdgcn_update_dpp(0, __builtin_bit_cast(int, v), 0x128, 0xf, 0xf, true));
    return v;
}
DI unsigned f2ord(float f) { const unsigned u = __float_as_uint(f); return (u & 0x80000000u) ? ~u : (u | 0x80000000u); }
DI float ord2f(unsigned o) { return __uint_as_float((o & 0x80000000u) ? (o & 0x7fffffffu) : ~o); }
DI unsigned umin(unsigned a, unsigned b) { return a < b ? a : b; }
DI unsigned top16_keys(unsigned (&k)[8], int c) {
#define CSWAP(i, j) { const unsigned hi_ = umax(k[i], k[j]), lo_ = umin(k[i], k[j]); k[i] = hi_; k[j] = lo_; }
    CSWAP(0, 1) CSWAP(2, 3) CSWAP(4, 5) CSWAP(6, 7)
    CSWAP(0, 2) CSWAP(1, 3) CSWAP(4, 6) CSWAP(5, 7)
    CSWAP(1, 2) CSWAP(5, 6)
    CSWAP(0, 4) CSWAP(1, 5) CSWAP(2, 6) CSWAP(3, 7)
    CSWAP(2, 4) CSWAP(3, 5)
    CSWAP(1, 2) CSWAP(3, 4) CSWAP(5, 6)
#undef CSWAP
    unsigned mine = 0u;
    for (int it = 0; it < 16; ++it) {
        const unsigned m = dpp_max16(k[0]);
        if (c == it) mine = m;
        const bool w = (k[0] == m);
#pragma unroll
        for (int i = 0; i < 7; ++i) k[i] = w ? k[i + 1] : k[i];
        k[7] = w ? 0u : k[7];
    }
    return mine;
}

DI void top16_keys2(unsigned (&ka)[8], unsigned (&kb)[8], int c, unsigned& ma, unsigned& mb) {
#define CSWAP2(i, j) { const unsigned ha_ = umax(ka[i], ka[j]), la_ = umin(ka[i], ka[j]); ka[i] = ha_; ka[j] = la_; \
                       const unsigned hb_ = umax(kb[i], kb[j]), lb_ = umin(kb[i], kb[j]); kb[i] = hb_; kb[j] = lb_; }
    CSWAP2(0, 1) CSWAP2(2, 3) CSWAP2(4, 5) CSWAP2(6, 7)
    CSWAP2(0, 2) CSWAP2(1, 3) CSWAP2(4, 6) CSWAP2(5, 7)
    CSWAP2(1, 2) CSWAP2(5, 6)
    CSWAP2(0, 4) CSWAP2(1, 5) CSWAP2(2, 6) CSWAP2(3, 7)
    CSWAP2(2, 4) CSWAP2(3, 5)
    CSWAP2(1, 2) CSWAP2(3, 4) CSWAP2(5, 6)
#undef CSWAP2
    ma = 0u; mb = 0u;
    for (int it = 0; it < 16; ++it) {
        const unsigned xa = dpp_max16(ka[0]), xb = dpp_max16(kb[0]);
        if (c == it) { ma = xa; mb = xb; }
        const bool wa = (ka[0] == xa), wb = (kb[0] == xb);
#pragma unroll
        for (int i = 0; i < 7; ++i) { ka[i] = wa ? ka[i + 1] : ka[i]; kb[i] = wb ? kb[i + 1] : kb[i]; }
        ka[7] = wa ? 0u : ka[7]; kb[7] = wb ? 0u : kb[7];
    }
}

template <int LAYER, int REP> DI void phase_peerA(const Params& p, unsigned char* smem) {
    unsigned char* ws = p.ws;
    const int tid = otid(), lane = tid & 63, wid = tid >> 6, c = lane & 15, Q = lane >> 4;
    unsigned char* wl = smem + 65536 + wid * 1024;
    float* ls1 = (float*)(wl) + Q * 16;
    int* li1 = (int*)(wl + 256) + Q * 16;
    float* lbs = (float*)(wl + 512) + Q * 16;
    int* le = (int*)(wl + 768) + Q * 16;
    const bf16_t* QH = (const bf16_t*)(ws + W_QH);
    {
        const u32x4* src = (const u32x4*)((const bf16_t*)(ws + W_SUBK) + (size_t)LAYER * 2 * 128 * 128);
        u32x4* dst = (u32x4*)smem;
#pragma unroll 4
        for (int i = tid; i < 4096; i += NTHREADS) dst[i] = src[i];
        __syncthreads();
    }
    const bf16_t* SUBK = (const bf16_t*)smem;
    const float* SU = (const float*)(ws + W_SU) + LAYER * NEXP;
    const float* SV = (const float*)(ws + W_SV) + LAYER * NEXP;
    unsigned short* SELE = (unsigned short*)(ws + W_SELE);
    float* SELG = (float*)(ws + W_SELG);
    float* SELU = (float*)(ws + W_SELU);
    unsigned* cnt = (unsigned*)(ws + W_CTL) + CTL_CNT_WORD + 64 * (1 + LAYER + 8 * REP);
    for (;;) {
        const int u = wave_next(cnt, lane);
        if (u >= (M / 16) * 8) break;
        const int row0 = (u >> 3) * 16, h = u & 7;
        f32x4 sc[2][8];
#pragma unroll
        for (int z = 0; z < 2; ++z)
#pragma unroll
            for (int nb = 0; nb < 8; ++nb) sc[z][nb] = (f32x4){0.f, 0.f, 0.f, 0.f};
#pragma unroll 1
        for (int ks = 0; ks < 4; ++ks)
#pragma unroll
            for (int z = 0; z < 2; ++z) {
                const bf16x8 a = *(const bf16x8*)(QH + ((size_t)((((row0 >> 4) * 8 + h) * 2 + z) * 4 + ks) * 64 + lane) * 8);
#pragma unroll
                for (int nb = 0; nb < 8; ++nb) {
                    const bf16x8 bq = *(const bf16x8*)(SUBK + ((size_t)((z * 8 + nb) * 4 + ks) * 64 + lane) * 8);
                    sc[z][nb] = MFMA16(a, bq, sc[z][nb]);
                }
            }
#pragma unroll
        for (int j = 0; j < 4; ++j) {
            const int row = row0 + Q * 4 + j;
            unsigned k0[8], k1[8];
#pragma unroll
            for (int nb = 0; nb < 8; ++nb) {
                k0[nb] = (f2ord(sc[0][nb][j]) & 0xffffff80u) | (unsigned)(127 - (nb * 16 + c));
                k1[nb] = (f2ord(sc[1][nb][j]) & 0xffffff80u) | (unsigned)(127 - (nb * 16 + c));
            }
            unsigned m0, m1;
            top16_keys2(k0, k1, c, m0, m1);
            const float s0 = ord2f(m0 & 0xffffff80u); const int i0 = 127 - (int)(m0 & 127u);
            ls1[c] = ord2f(m1 & 0xffffff80u); li1[c] = 127 - (int)(m1 & 127u);
            wave_lds_sync();
            int pp = 0; float s1p = ls1[0]; int i1p = li1[0];
            for (int it = 0; it < 16; ++it) {
                const float cand = s0 + s1p;
                const unsigned key = (pp < 16) ? ((f2ord(cand) & 0xffffff00u) | (unsigned)(255 - (c * 16 + pp))) : 0u;
                const unsigned mk = dpp_max16(key);
                if (key == mk) {
                    le[it] = i0 * 128 + i1p; lbs[it] = cand;
                    ++pp; s1p = ls1[pp & 15]; i1p = li1[pp & 15];
                }
            }
            wave_lds_sync();
            const int e = le[c];
            const float ex = __expf(lbs[c] - lbs[0]);
            const float sm = dpp_sum16(ex);
            const size_t o = (size_t)row * 128 + h * 16 + c;
            SELE[o] = (unsigned short)e;
            SELG[o] = ex / sm * SV[e];
            SELU[o] = SU[e];
            wave_lds_sync();
        }
    }
    __syncthreads();
}

template <int LAYER, int REP> DI void phase_peerB(const Params& p, unsigned char* smem) {
    constexpr bool DRY = REP != 0;
    unsigned char* ws = p.ws;
    const int tid = otid(), lane = tid & 63, wid = tid >> 6, c = lane & 15, Q = lane >> 4;
    unsigned char* xq = smem + wid * 1024;
    const unsigned char* U8 = ws + W_U8 + (size_t)LAYER * NEXP * 1024;
    const unsigned char* V8 = ws + W_V8 + (size_t)LAYER * NEXP * 1024;
    const bf16_t* XH = (const bf16_t*)(ws + W_XHAT);
    float* XR = (float*)(ws + W_XR);
    const unsigned short* SELE = (const unsigned short*)(ws + W_SELE);
    const float* SELG = (const float*)(ws + W_SELG);
    const float* SELU = (const float*)(ws + W_SELU);
    unsigned* cnt = (unsigned*)(ws + W_CTL) + CTL_CNT_WORD + 64 * (5 + LAYER + 8 * REP);
    for (;;) {
        const int row = wave_next(cnt, lane);
        if (row >= M) break;
        const int eA = (int)SELE[(size_t)row * 128 + lane], eB = (int)SELE[(size_t)row * 128 + 64 + lane];
        const float gA = SELG[(size_t)row * 128 + lane], gB = SELG[(size_t)row * 128 + 64 + lane];
        const float uA = SELU[(size_t)row * 128 + lane], uB = SELU[(size_t)row * 128 + 64 + lane];
        const float xs = ((const float*)(ws + W_SA))[row];
        *(u32x4*)(xq + lane * 16) = *(const u32x4*)(ws + W_XQ + (size_t)row * D + lane * 16);
        wave_lds_sync();
        float w[8][4];
        i32x4 uf[16];
        {
            const int ec0 = __shfl(eA, c);
            const unsigned char* ur = U8 + (size_t)ec0 * 1024 + Q * 16;
#pragma unroll
            for (int ks = 0; ks < 16; ++ks) uf[ks] = *(const i32x4*)(ur + ks * 64);
        }
#pragma unroll
        for (int G = 0; G < 8; ++G) {
            float su4[4], g4[4];
            {
                const int src = (G & 3) * 16 + 4 * Q;
#pragma unroll
                for (int j = 0; j < 4; ++j) { g4[j] = __shfl(G < 4 ? gA : gB, src + j); su4[j] = __shfl(G < 4 ? uA : uB, src + j); }
            }
            i32x4 di = {0, 0, 0, 0};
#pragma unroll
            for (int kq = 0; kq < 4; ++kq) {
                i32x4 xb[4];
#pragma unroll
                for (int k2 = 0; k2 < 4; ++k2) xb[k2] = *(const i32x4*)(xq + (kq * 4 + k2) * 64 + Q * 16);
#pragma unroll
                for (int k2 = 0; k2 < 4; ++k2) di = MFMA_I8(uf[kq * 4 + k2], xb[k2], di);
                __builtin_amdgcn_sched_barrier(0);
            }
            if (G < 7) {
                const int ecn = __shfl((G + 1) < 4 ? eA : eB, ((G + 1) & 3) * 16 + c);
                const unsigned char* ur = U8 + (size_t)ecn * 1024 + Q * 16;
#pragma unroll
                for (int ks = 0; ks < 16; ++ks) uf[ks] = *(const i32x4*)(ur + ks * 64);
            }
#pragma unroll
            for (int j = 0; j < 4; ++j) w[G][j] = g4[j] * gelu_tanh((float)di[j] * su4[j] * xs);
            __builtin_amdgcn_sched_barrier(0);
        }
        float wmax = 0.f;
#pragma unroll
        for (int G = 0; G < 8; ++G)
#pragma unroll
            for (int j = 0; j < 4; ++j) wmax = fmaxf(wmax, fabsf(w[G][j]));
        wmax = fmaxf(wmax, __shfl_xor(wmax, 16)); wmax = fmaxf(wmax, __shfl_xor(wmax, 32));
        const float winv = wmax > 0.f ? 127.0f / wmax : 0.f;
        int wq[8];
#pragma unroll
        for (int G = 0; G < 8; ++G) {
            const int q0 = (int)rintf(w[G][0] * winv), q1 = (int)rintf(w[G][1] * winv), q2 = (int)rintf(w[G][2] * winv), q3 = (int)rintf(w[G][3] * winv);
            wq[G] = (int)((unsigned)(q0 & 255) | ((unsigned)(q1 & 255) << 8) | ((unsigned)(q2 & 255) << 16) | ((unsigned)(q3 & 255) << 24));
        }
        int ai[16];
#pragma unroll
        for (int i = 0; i < 16; ++i) ai[i] = 0;
        i32x4 VA[4], VB[4];
#define PB_VLOAD(V, grp) { _Pragma("unroll") for (int j_ = 0; j_ < 4; ++j_) { \
            const int es_ = __builtin_amdgcn_readlane(((grp) >> 2) < 4 ? eA : eB, ((((grp) >> 2) & 3) * 16 + ((grp) & 3) * 4 + j_)); \
            V[j_] = *(const i32x4*)(V8 + (size_t)es_ * 1024 + lane * 16); } }
#define PB_VDOT(V, grp) { const int wd_ = __builtin_amdgcn_readlane(wq[(grp) >> 2], 16 * ((grp) & 3)); \
            _Pragma("unroll") for (int i_ = 0; i_ < 4; ++i_) { \
                const unsigned A_ = (unsigned)V[0][i_], B_ = (unsigned)V[1][i_], C_ = (unsigned)V[2][i_], D_ = (unsigned)V[3][i_]; \
                const unsigned P0_ = __builtin_amdgcn_perm(B_, A_, 0x05010400u), P2_ = __builtin_amdgcn_perm(B_, A_, 0x07030602u); \
                const unsigned Q0_ = __builtin_amdgcn_perm(D_, C_, 0x05010400u), Q2_ = __builtin_amdgcn_perm(D_, C_, 0x07030602u); \
                ai[4 * i_ + 0] = __builtin_amdgcn_sdot4((int)__builtin_amdgcn_perm(Q0_, P0_, 0x05040100u), wd_, ai[4 * i_ + 0], false); \
                ai[4 * i_ + 1] = __builtin_amdgcn_sdot4((int)__builtin_amdgcn_perm(Q0_, P0_, 0x07060302u), wd_, ai[4 * i_ + 1], false); \
                ai[4 * i_ + 2] = __builtin_amdgcn_sdot4((int)__builtin_amdgcn_perm(Q2_, P2_, 0x05040100u), wd_, ai[4 * i_ + 2], false); \
                ai[4 * i_ + 3] = __builtin_amdgcn_sdot4((int)__builtin_amdgcn_perm(Q2_, P2_, 0x07060302u), wd_, ai[4 * i_ + 3], false); } }
        PB_VLOAD(VA, 0);
#pragma unroll
        for (int grp = 0; grp < 32; grp += 2) {
            PB_VLOAD(VB, grp + 1);
            PB_VDOT(VA, grp);
            if (grp + 2 < 32) PB_VLOAD(VA, grp + 2);
            PB_VDOT(VB, grp + 1);
        }
#undef PB_VLOAD
#undef PB_VDOT
        float acc[16];
        {
            const float ws_ = wmax * (1.0f / 127.0f);
#pragma unroll
            for (int i = 0; i < 16; ++i) acc[i] = (float)ai[i] * ws_;
        }
        const float wsum = 0.f;
        float* xr = XR + (size_t)row * D + lane * 16;
        float* xw = DRY ? (float*)(ws + W_END) + (size_t)row * D + lane * 16 : xr;
        float x[16]; float ss = 0.f;
#pragma unroll
        for (int i = 0; i < 4; ++i) { const float4 t = ((const float4*)xr)[i]; x[4 * i] = t.x; x[4 * i + 1] = t.y; x[4 * i + 2] = t.z; x[4 * i + 3] = t.w; }
#pragma unroll
        for (int i = 0; i < 16; ++i) { x[i] += acc[i] - 128.0f * wsum; ss += x[i] * x[i]; }
        ss = wave_sum(ss);
        const float rs = rsqrtf(ss * (1.0f / D) + 1e-6f);
        if (LAYER == 0) {
#pragma unroll
            for (int i = 0; i < 4; ++i) ((float4*)xw)[i] = make_float4(x[4 * i], x[4 * i + 1], x[4 * i + 2], x[4 * i + 3]);
            float am = 0.f;
#pragma unroll
            for (int i = 0; i < 16; ++i) am = fmaxf(am, fabsf(x[i]));
#pragma unroll
            for (int off = 32; off >= 1; off >>= 1) am = fmaxf(am, __shfl_xor(am, off));
            const float inv = am > 0.f ? 127.0f / am : 0.f;
            u32x4 o;
#pragma unroll
            for (int i = 0; i < 4; ++i) {
                const int q0 = (int)rintf(x[4 * i] * inv), q1 = (int)rintf(x[4 * i + 1] * inv), q2 = (int)rintf(x[4 * i + 2] * inv), q3 = (int)rintf(x[4 * i + 3] * inv);
                o[i] = (unsigned)(q0 & 255) | ((unsigned)(q1 & 255) << 8) | ((unsigned)(q2 & 255) << 16) | ((unsigned)(q3 & 255) << 24);
            }
            *(u32x4*)(ws + (DRY ? W_END + (size_t)M * D * 4 : W_XQ) + (size_t)row * D + lane * 16) = o;
            if (lane == 0 && !DRY) ((float*)(ws + W_SA))[row] = rs * am * (1.0f / 127.0f);
        } else {
            float* y = DRY ? xw : (row < MP ? p.out + O_YP + (size_t)row * D : p.out + O_YS + (size_t)(row - MP) * D) + lane * 16;
            const float4* gf = (const float4*)(p.g_final + lane * 16);
#pragma unroll
            for (int i = 0; i < 4; ++i) { const float4 g = gf[i];
                ((float4*)y)[i] = make_float4(x[4 * i] * rs * g.x, x[4 * i + 1] * rs * g.y, x[4 * i + 2] * rs * g.z, x[4 * i + 3] * rs * g.w); }
        }
        wave_lds_sync();
    }
}

constexpr int CW_LD = 264;
constexpr int CW_TILE = 64 * CW_LD;
template <int REP> DI void phase_compress(const Params& p, unsigned char* smem) {
    unsigned char* ws = p.ws;
    const int tid = otid(), lane = tid & 63, wid = tid >> 6, c = lane & 15, Q = lane >> 4;
    bf16_t* Wl = (bf16_t*)smem;
    int* sh_unit = (int*)(smem + 2 * CW_TILE * 2);
    unsigned* cnt = (unsigned*)(ws + W_CTL) + CTL_CNT_WORD + 64 * (3 + 8 * REP);
    const float* pet = (const float*)(ws + W_PET);
    const float2* tab = (const float2*)(ws + W_ROPE);
    const int NU = 34 * 4 * 2 * 9;
    const int wf = tid >> 2, wpart = (tid & 3) * 64;
    for (;;) {
        if (tid == 0) *sh_unit = (int)__hip_atomic_fetch_add(cnt, 1u, __ATOMIC_RELAXED, __HIP_MEMORY_SCOPE_AGENT);
        __syncthreads();
        const int u = __builtin_amdgcn_readfirstlane(*sh_unit);
        __syncthreads();
        if (u >= NU) break;
        const int u9 = u / 9, wv = (u - u9 * 9) * 4 + wid, z = u9 & 1, kvh = (u9 >> 1) & 3, bo = u9 >> 3;
        const int bb = bo < 32 ? bo + 2 : bo - 32;
        int blk = wv * 15 + c;
        const bool colok = (c < 15) && (blk < 511);
        blk = blk > 511 ? 511 : blk;
        const bf16_t* W1 = (const bf16_t*)(ws + W_WC1) + (size_t)z * 64 * 2048;
        const bf16_t* W2 = (const bf16_t*)(ws + W_WC2) + (size_t)z * 4096;
        f32x4 hid[4];
#pragma unroll
        for (int i = 0; i < 4; ++i) hid[i] = (f32x4){0.f, 0.f, 0.f, 0.f};
        bf16x8 wr[8];
#define W_LOAD(g) { _Pragma("unroll") for (int i_ = 0; i_ < 8; ++i_) wr[i_] = *(const bf16x8*)(W1 + (size_t)wf * 2048 + (g) * 256 + wpart + i_ * 8); }
#define W_STORE(buf) { _Pragma("unroll") for (int i_ = 0; i_ < 8; ++i_) *(bf16x8*)&Wl[(buf) * CW_TILE + wf * CW_LD + wpart + i_ * 8] = wr[i_]; }
#define C_MMA(BF, u_, h_, buf) { const bf16x8 bq_ = (BF); _Pragma("unroll") for (int fb = 0; fb < 4; ++fb) \
            hid[fb] = MFMA16(*(const bf16x8*)&Wl[(buf) * CW_TILE + (fb * 16 + c) * CW_LD + ((u_) * 2 + (h_)) * 32 + Q * 8], bq_, hid[fb]); }
        if (bb < 2) {
            const bf16_t* src = (const bf16_t*)(ws + (z == 0 ? W_CMPK : W_CMPV));
            bf16x8 E0[4][2], E1[4][2];
#define E_LOAD(E, g) { _Pragma("unroll") for (int u_ = 0; u_ < 4; ++u_) { int t_ = blk * 16 + (g) * 4 + u_; t_ = t_ > SEQ - 1 ? SEQ - 1 : t_; \
                const bf16_t* r_ = src + ((size_t)(bb * SEQ + t_) * 4 + kvh) * 64 + Q * 8; E[u_][0] = *(const bf16x8*)r_; E[u_][1] = *(const bf16x8*)(r_ + 32); } }
#define E_STEP(G, Ec, En) { const int g_ = (G); if (g_ + 1 < 8) { W_LOAD(g_ + 1); E_LOAD(En, g_ + 1); } \
                _Pragma("unroll") for (int u_ = 0; u_ < 4; ++u_) { C_MMA(Ec[u_][0], u_, 0, g_ & 1); C_MMA(Ec[u_][1], u_, 1, g_ & 1); } \
                if (g_ + 1 < 8) W_STORE((g_ + 1) & 1); lds_barrier(); }
            W_LOAD(0); E_LOAD(E0, 0); W_STORE(0); lds_barrier();
#pragma unroll 1
            for (int g = 0; g < 8; g += 2) { E_STEP(g, E0, E1); E_STEP(g + 1, E1, E0); }
#undef E_LOAD
#undef E_STEP
        } else {
            const int bd = bb - 2;
            const int* pt = p.page_table + bd * NPAGE;
            const int pg0 = pt[(blk * 16) >> 7];
            const int wr_ = (tid & 3) >> 1, wh_ = tid & 1;
            float4 D0[2][4], D1[2][4];
#define W_LOAD2(g) { _Pragma("unroll") for (int i_ = 0; i_ < 8; ++i_) wr[i_] = *(const bf16x8*)(W1 + (size_t)wf * 2048 + (wh_ * 16 + 2 * (g) + wr_) * 64 + i_ * 8); }
#define D_LOAD2(D, g) { _Pragma("unroll") for (int r_ = 0; r_ < 2; ++r_) { \
                const int l_ = 2 * (g) + r_; \
                const float* p_ = p.cache_b_kv + ((size_t)(pg0 * 128 + ((blk * 16 + l_) & 127)) * 4 + z) * 256 + kvh * 64 + Q * 8; \
                D[r_][0] = *(const float4*)p_; D[r_][1] = *(const float4*)(p_ + 4); D[r_][2] = *(const float4*)(p_ + 32); D[r_][3] = *(const float4*)(p_ + 36); \
} }
#define C_MMA2(BF, koff, buf) { const bf16x8 bq_ = (BF); _Pragma("unroll") for (int fb = 0; fb < 4; ++fb) \
            hid[fb] = MFMA16(*(const bf16x8*)&Wl[(buf) * CW_TILE + (fb * 16 + c) * CW_LD + (koff) + Q * 8], bq_, hid[fb]); }
#define D_STEP2(G, Dc, Dn) { const int g_ = (G); if (g_ + 1 < 8) { W_LOAD2(g_ + 1); D_LOAD2(Dn, g_ + 1); } \
                _Pragma("unroll") for (int r_ = 0; r_ < 2; ++r_) _Pragma("unroll") for (int kc_ = 0; kc_ < 2; ++kc_) { \
                    const bf16x8 lo_ = pack8(Dc[r_][2 * kc_].x, Dc[r_][2 * kc_].y, Dc[r_][2 * kc_].z, Dc[r_][2 * kc_].w, Dc[r_][2 * kc_ + 1].x, Dc[r_][2 * kc_ + 1].y, Dc[r_][2 * kc_ + 1].z, Dc[r_][2 * kc_ + 1].w); \
                    const u32x4 lw_ = __builtin_bit_cast(u32x4, lo_); u32x4 hw_; \
                    hw_.x = (unsigned)__shfl((int)lw_.x, lane + 1); hw_.y = (unsigned)__shfl((int)lw_.y, lane + 1); hw_.z = (unsigned)__shfl((int)lw_.z, lane + 1); hw_.w = (unsigned)__shfl((int)lw_.w, lane + 1); \
                    C_MMA2(lo_, (r_ * 2 + 0) * 64 + kc_ * 32, g_ & 1); \
                    C_MMA2(__builtin_bit_cast(bf16x8, hw_), (r_ * 2 + 1) * 64 + kc_ * 32, g_ & 1); } \
                if (g_ + 1 < 8) W_STORE((g_ + 1) & 1); lds_barrier(); }
            W_LOAD2(0); D_LOAD2(D0, 0); W_STORE(0); lds_barrier();
#pragma unroll 1
            for (int g = 0; g < 8; g += 2) { D_STEP2(g, D0, D1); D_STEP2(g + 1, D1, D0); }
#undef W_LOAD2
#undef D_LOAD2
#undef C_MMA2
#undef D_STEP2
        }
#undef W_LOAD
#undef W_STORE
#undef C_MMA
#pragma unroll
        for (int fb = 0; fb < 4; ++fb)
#pragma unroll
            for (int j = 0; j < 4; ++j) hid[fb][j] = gelu_tanh(hid[fb][j] + pet[z * 64 + fb * 16 + 4 * Q + j]);
        f32x4 ot[4];
#pragma unroll
        for (int i = 0; i < 4; ++i) ot[i] = (f32x4){0.f, 0.f, 0.f, 0.f};
#pragma unroll
        for (int kb = 0; kb < 2; ++kb) {
            const bf16x8 hb = pack8(hid[2 * kb][0], hid[2 * kb][1], hid[2 * kb][2], hid[2 * kb][3], hid[2 * kb + 1][0], hid[2 * kb + 1][1], hid[2 * kb + 1][2], hid[2 * kb + 1][3]);
#pragma unroll
            for (int db = 0; db < 4; ++db) {
                const bf16x4 lo = *(const bf16x4*)(W2 + (size_t)(db * 16 + c) * 64 + kb * 32 + 4 * Q);
                const bf16x4 hi = *(const bf16x4*)(W2 + (size_t)(db * 16 + c) * 64 + kb * 32 + 16 + 4 * Q);
                const bf16x8 a = __builtin_shufflevector(lo, hi, 0, 1, 2, 3, 4, 5, 6, 7);
                ot[db] = MFMA16(a, hb, ot[db]);
            }
        }
        if (z == 0) {
            const int pos = blk * 16 + 31;
#pragma unroll
            for (int j = 0; j < 4; ++j) {
                const float partner = __shfl_xor(ot[0][j], 32);
                const int pc = pos > 8199 ? 8199 : pos;
                const float2 cs = tab[pc * 8 + ((4 * Q + j) & 7)];
                ot[0][j] = (Q < 2) ? ot[0][j] * cs.x - partner * cs.y : ot[0][j] * cs.x + partner * cs.y;
            }
            if (colok) {
                bf16_t* KC = (bf16_t*)(ws + W_KC) + ((size_t)(bb * 4 + kvh) * 512 + blk) * 64;
#pragma unroll
                for (int db = 0; db < 4; ++db) { u32x2 w; w.x = pk2(ot[db][0], ot[db][1]); w.y = pk2(ot[db][2], ot[db][3]); *(u32x2*)(KC + db * 16 + 4 * Q) = w; }
            }
        } else if (colok) {
            bf16_t* VCT = (bf16_t*)(ws + W_VCT) + (size_t)(bb * 4 + kvh) * 64 * 512;
#pragma unroll
            for (int db = 0; db < 4; ++db)
#pragma unroll
                for (int j = 0; j < 4; ++j) VCT[(size_t)(db * 16 + 4 * Q + j) * 512 + blk] = (bf16_t)f2bf(ot[db][j]);
        }
    }
}

constexpr int KT_LD = 72;
constexpr int KT_ELEMS = 64 * KT_LD;
struct TileRegsBf { bf16x8 k0, k1, v0, v1; };
struct TileRegsF { float4 k[4], v[4]; };

DI void attn_tile64(const bf16x8& q0, const bf16x8& q1, const bf16_t* Kl, const bf16_t* VTl, int key0, bool rowok, int klo, int khi,
                    float& m, float& l, f32x4 (&o)[4], int c, int Q) {
    const float ninit = rowok ? -m : NEG_INF;
    f32x4 s[4];
#pragma unroll
    for (int sub = 0; sub < 4; ++sub) {
        s[sub] = (f32x4){ninit, ninit, ninit, ninit};
        s[sub] = MFMA16(*(const bf16x8*)&Kl[(sub * 16 + c) * KT_LD + Q * 8], q0, s[sub]);
        s[sub] = MFMA16(*(const bf16x8*)&Kl[(sub * 16 + c) * KT_LD + 32 + Q * 8], q1, s[sub]);
    }
    if (__any(rowok && (key0 < klo || key0 + 63 > khi))) {
        const unsigned span = (unsigned)(khi - klo);
        const int kb = key0 + 4 * Q - klo;
#pragma unroll
        for (int sub = 0; sub < 4; ++sub)
#pragma unroll
            for (int j = 0; j < 4; ++j) if ((unsigned)(kb + sub * 16 + j) > span) s[sub][j] = NEG_INF;
    }
    float mx = fmaxf(fmaxf(fmaxf(s[0][0], s[0][1]), fmaxf(s[0][2], s[0][3])), fmaxf(fmaxf(s[1][0], s[1][1]), fmaxf(s[1][2], s[1][3])));
    mx = fmaxf(mx, fmaxf(fmaxf(fmaxf(s[2][0], s[2][1]), fmaxf(s[2][2], s[2][3])), fmaxf(fmaxf(s[3][0], s[3][1]), fmaxf(s[3][2], s[3][3]))));
    if (__any(mx > LAZY_T)) {
        float mr = mx + m;
        mr = fmaxf(mr, __shfl_xor(mr, 16)); mr = fmaxf(mr, __shfl_xor(mr, 32));
        const float mn = fmaxf(m, mr);
        const float shift = mn - m;
        const float alpha = fexp2(-shift);
        l *= alpha; m = mn;
#pragma unroll
        for (int db = 0; db < 4; ++db) o[db] = o[db] * alpha;
#pragma unroll
        for (int sub = 0; sub < 4; ++sub)
#pragma unroll
            for (int j = 0; j < 4; ++j) s[sub][j] -= shift;
    }
#pragma unroll
    for (int sub = 0; sub < 4; ++sub)
#pragma unroll
        for (int j = 0; j < 4; ++j) { s[sub][j] = fexp2(s[sub][j]); l += s[sub][j]; }
#pragma unroll
    for (int half = 0; half < 2; ++half) {
        const bf16x8 pb = pack8(s[2 * half][0], s[2 * half][1], s[2 * half][2], s[2 * half][3], s[2 * half + 1][0], s[2 * half + 1][1], s[2 * half + 1][2], s[2 * half + 1][3]);
#pragma unroll
        for (int db = 0; db < 4; ++db) {
            const bf16x4 lo = *(const bf16x4*)&VTl[(db * 16 + c) * KT_LD + half * 32 + 4 * Q];
            const bf16x4 hi = *(const bf16x4*)&VTl[(db * 16 + c) * KT_LD + half * 32 + 16 + 4 * Q];
            o[db] = MFMA16(__builtin_shufflevector(lo, hi, 0, 1, 2, 3, 4, 5, 6, 7), pb, o[db]);
        }
    }
}

struct SrcBf {
    const bf16_t* K; const bf16_t* VT; int ldv;
    typedef TileRegsBf Regs;
    DI void load(Regs& r, int key0, int tid, bool needv) const {
        const int i0 = tid, i1 = tid + 256;
        r.k0 = *(const bf16x8*)(K + (size_t)(key0 + (i0 >> 3)) * 64 + (i0 & 7) * 8);
        r.k1 = *(const bf16x8*)(K + (size_t)(key0 + (i1 >> 3)) * 64 + (i1 & 7) * 8);
        if (needv) {
            r.v0 = *(const bf16x8*)(VT + (size_t)(i0 >> 3) * ldv + key0 + (i0 & 7) * 8);
            r.v1 = *(const bf16x8*)(VT + (size_t)(i1 >> 3) * ldv + key0 + (i1 & 7) * 8);
        }
    }
    DI void store(const Regs& r, bf16_t* Kl, bf16_t* VTl, int tid, bool needv) const {
        const int i0 = tid, i1 = tid + 256;
        *(bf16x8*)&Kl[(i0 >> 3) * KT_LD + (i0 & 7) * 8] = r.k0;
        *(bf16x8*)&Kl[(i1 >> 3) * KT_LD + (i1 & 7) * 8] = r.k1;
        if (needv) {
            *(bf16x8*)&VTl[(i0 >> 3) * KT_LD + (i0 & 7) * 8] = r.v0;
            *(bf16x8*)&VTl[(i1 >> 3) * KT_LD + (i1 & 7) * 8] = r.v1;
        }
    }
};
template <class RowF> struct SrcF32 {
    RowF rf;
    typedef TileRegsF Regs;
    DI void load(Regs& r, int key0, int tid, bool needv) const {
        const int key = key0 + (tid >> 2), qd = (tid & 3) * 16;
        const float4* kp = (const float4*)(rf(key, 0) + qd);
#pragma unroll
        for (int i = 0; i < 4; ++i) r.k[i] = kp[i];
        if (needv) {
            const float4* vp = (const float4*)(rf(key, 1) + qd);
#pragma unroll
            for (int i = 0; i < 4; ++i) r.v[i] = vp[i];
        }
    }
    DI void store(const Regs& r, bf16_t* Kl, bf16_t* VTl, int tid, bool needv) const {
        const int kl = tid >> 2, qd = (tid & 3) * 16;
        u32x4 a, b2;
        a.x = pk2(r.k[0].x, r.k[0].y); a.y = pk2(r.k[0].z, r.k[0].w); a.z = pk2(r.k[1].x, r.k[1].y); a.w = pk2(r.k[1].z, r.k[1].w);
        b2.x = pk2(r.k[2].x, r.k[2].y); b2.y = pk2(r.k[2].z, r.k[2].w); b2.z = pk2(r.k[3].x, r.k[3].y); b2.w = pk2(r.k[3].z, r.k[3].w);
        *(u32x4*)&Kl[kl * KT_LD + qd] = a; *(u32x4*)&Kl[kl * KT_LD + qd + 8] = b2;
        if (needv) {
#pragma unroll
            for (int i = 0; i < 4; ++i) {
                VTl[(qd + 4 * i + 0) * KT_LD + kl] = (bf16_t)f2bf(r.v[i].x);
                VTl[(qd + 4 * i + 1) * KT_LD + kl] = (bf16_t)f2bf(r.v[i].y);
                VTl[(qd + 4 * i + 2) * KT_LD + kl] = (bf16_t)f2bf(r.v[i].z);
                VTl[(qd + 4 * i + 3) * KT_LD + kl] = (bf16_t)f2bf(r.v[i].w);
            }
        }
    }
};

struct LinIter { int k; DI int next() { const int r = k; k += 64; return r; } };
struct BitIter {
    unsigned r0, r1, r2, r3;
    DI int next() {
        int jb;
        if (r0) { jb = __builtin_ctz(r0); r0 &= r0 - 1; }
        else if (r1) { jb = 32 + __builtin_ctz(r1); r1 &= r1 - 1; }
        else if (r2) { jb = 64 + __builtin_ctz(r2); r2 &= r2 - 1; }
        else if (r3) { jb = 96 + __builtin_ctz(r3); r3 &= r3 - 1; }
        else jb = 128;
        return jb * 64;
    }
};
template <class Src, class Iter, class CompF>
DI void coop_tiles(const Src& src, int nsteps, bool needv, Iter it, CompF&& comp, bf16_t* Kl, bf16_t* VTl, int tid) {
    typename Src::Regs regs;
    int knext = 0;
    if (nsteps > 0) { knext = it.next(); src.load(regs, knext, tid, needv); src.store(regs, Kl, VTl, tid, needv); }
    lds_barrier();
    for (int s = 0; s < nsteps; ++s) {
        const int buf = s & 1, kcur = knext;
        if (s + 1 < nsteps) { knext = it.next(); src.load(regs, knext, tid, needv); }
        comp(s, kcur, Kl + buf * KT_ELEMS, VTl + buf * KT_ELEMS);
        if (s + 1 < nsteps) src.store(regs, Kl + (buf ^ 1) * KT_ELEMS, VTl + (buf ^ 1) * KT_ELEMS, tid, needv);
        lds_barrier();
    }
}
template <class Src, class Iter, class CompF>
DI void coop_tiles4(const Src& src, int nsteps, bool needv, Iter it, CompF&& comp, bf16_t* Kl, bf16_t* VTl, int tid) {
    typename Src::Regs R0, R1;
    int k0 = 0, k1 = 0;
    if (nsteps > 0) { k0 = it.next(); src.load(R0, k0, tid, needv); }
    if (nsteps > 1) { k1 = it.next(); src.load(R1, k1, tid, needv); }
    if (nsteps > 0) src.store(R0, Kl, VTl, tid, needv);
    lds_barrier();
#define CT4_STEP(S, Ra, ka, Rb) { const int s_ = (S); const int kcur_ = ka; \
        if (s_ + 2 < nsteps) { ka = it.next(); src.load(Ra, ka, tid, needv); } \
        comp(s_, kcur_, Kl + (s_ & 1) * KT_ELEMS, VTl + (s_ & 1) * KT_ELEMS); \
        if (s_ + 1 < nsteps) src.store(Rb, Kl + ((s_ + 1) & 1) * KT_ELEMS, VTl + ((s_ + 1) & 1) * KT_ELEMS, tid, needv); \
        lds_barrier(); }
    for (int s = 0; s < nsteps; s += 2) {
        CT4_STEP(s, R0, k0, R1);
        if (s + 1 < nsteps) CT4_STEP(s + 1, R1, k1, R0);
    }
#undef CT4_STEP
}

constexpr int ST2_BYTES = 4 * KT_ELEMS * 2;
template <class Src, class Iter, class CompF>
DI void coop_tiles2x(const Src& src, int ntiles, bool needv, Iter it, CompF&& comp, unsigned char* tiles, int tid) {
    typename Src::Regs RA, RB;
    int kA = 0, kB = 0;
    const int nst = (ntiles + 1) >> 1;
#define ST2_K(st, ab) ((bf16_t*)(tiles + (st) * ST2_BYTES) + (ab) * KT_ELEMS)
#define ST2_V(st, ab) ((bf16_t*)(tiles + (st) * ST2_BYTES) + (2 + (ab)) * KT_ELEMS)
    if (nst > 0) {
        kA = it.next(); src.load(RA, kA, tid, needv);
        if (ntiles > 1) { kB = it.next(); src.load(RB, kB, tid, needv); }
        src.store(RA, ST2_K(0, 0), ST2_V(0, 0), tid, needv);
        if (ntiles > 1) src.store(RB, ST2_K(0, 1), ST2_V(0, 1), tid, needv);
    }
    lds_barrier();
    for (int s = 0; s < nst; ++s) {
        const int cA = kA, cB = kB, st = s & 1;
        const bool vB = (2 * s + 1 < ntiles), more = (s + 1 < nst), nB = (2 * s + 3 < ntiles);
        if (more) { kA = it.next(); src.load(RA, kA, tid, needv); if (nB) { kB = it.next(); src.load(RB, kB, tid, needv); } }
        comp(2 * s, cA, ST2_K(st, 0), ST2_V(st, 0));
        if (vB) comp(2 * s + 1, cB, ST2_K(st, 1), ST2_V(st, 1));
        if (more) { src.store(RA, ST2_K(st ^ 1, 0), ST2_V(st ^ 1, 0), tid, needv); if (nB) src.store(RB, ST2_K(st ^ 1, 1), ST2_V(st ^ 1, 1), tid, needv); }
        lds_barrier();
    }
#undef ST2_K
#undef ST2_V
}

template <bool SAMPLE, int PV = 0> DI void nsa_block_unit(const Params& p, int unit, unsigned char* smem, int tid) {
    unsigned char* ws = p.ws;
    const int lane = tid & 63, wid = tid >> 6, c = lane & 15, Q = lane >> 4, qi = c >> 2, gq = c & 3;
    bf16_t* Kl = (bf16_t*)smem;
    bf16_t* VTl = Kl + 2 * KT_ELEMS;
    float* imp = (float*)(smem + 18432) + wid * 512;
    unsigned* msk = (unsigned*)(smem + 2 * ST2_BYTES) + wid * 16;
    unsigned* bun = (unsigned*)(smem + 2 * ST2_BYTES + 256);
    int b, kvh, t0blk;
    if (!SAMPLE) { t0blk = (511 - (unit & 511)) * 16; kvh = (unit >> 9) & 3; b = unit >> 11; }
    else { t0blk = 0; kvh = unit & 3; b = unit >> 2; }
    const bool wactive = SAMPLE ? (wid < 2) : true;
    const int qn = wactive ? wid * 4 + qi : qi;
    const int bb = SAMPLE ? 2 + b : b;
    const int qbase = SAMPLE ? PAST : t0blk;
    const int qpos = qbase + qn;
    const int qmax_blk = qbase + (SAMPLE ? 7 : 15);
    const int trow = SAMPLE ? MP + b * 8 + qn : b * SEQ + t0blk + qn;
    const int hq = kvh * 4 + gq;
    const bf16_t* qp = (const bf16_t*)(ws + W_QB) + (size_t)trow * 1024 + hq * 64 + Q * 8;
    const bf16x8 q0 = *(const bf16x8*)qp, q1 = *(const bf16x8*)(qp + 32);
    const float* gp = (const float*)(ws + W_GATE) + (size_t)trow * 48 + hq * 3;
    const float g_c = gp[0], g_s = gp[1], g_w = gp[2];
    f32x4 outacc[4], o[4];
#pragma unroll
    for (int i = 0; i < 4; ++i) { outacc[i] = (f32x4){0.f, 0.f, 0.f, 0.f}; o[i] = (f32x4){0.f, 0.f, 0.f, 0.f}; }
    float m = 0.f, l = 0.f;
    const int nhi = (qpos - 31) >> 4;
    SrcBf srcc;
    srcc.K = (const bf16_t*)(ws + W_KC) + (size_t)(bb * 4 + kvh) * 512 * 64;
    srcc.VT = (const bf16_t*)(ws + W_VCT) + (size_t)(bb * 4 + kvh) * 64 * 512;
    srcc.ldv = 512;
    const int nmax = (qmax_blk - 31) >> 4;
    const int ncs = nmax >= 0 ? (nmax >> 6) + 1 : 0;
    coop_tiles2x(srcc, ncs, true, LinIter{0},
        [&](int, int n0, const bf16_t* kl, const bf16_t* vl) {
            if (PV == 1) return;
            if (wactive) attn_tile64(q0, q1, kl, vl, n0, nhi >= 0, 0, nhi, m, l, o, c, Q);
        }, smem, tid);
    const float lcs = row_sum(l);
    const float inv_lc = lcs > 0.f ? 1.0f / lcs : 0.f;
#pragma unroll
    for (int db = 0; db < 4; ++db) outacc[db] += o[db] * (g_c * inv_lc);
#pragma unroll
    for (int i = 0; i < 8; ++i) imp[lane + 64 * i] = 0.f;
    if (lane < 16) msk[lane] = 0u;
    if (tid < 4) bun[tid] = 0u;
    {
        const float mu = m;
        float rprev = 0.f;
        coop_tiles2x(srcc, ncs, false, LinIter{0},
            [&](int, int n0, const bf16_t* kl, const bf16_t*) {
                if (!wactive) return;
#pragma unroll
                for (int sub = 0; sub < 4; ++sub) {
                    f32x4 sv = {0.f, 0.f, 0.f, 0.f};
                    sv = MFMA16(*(const bf16x8*)&kl[(sub * 16 + c) * KT_LD + Q * 8], q0, sv);
                    sv = MFMA16(*(const bf16x8*)&kl[(sub * 16 + c) * KT_LD + 32 + Q * 8], q1, sv);
                    float pr[4];
#pragma unroll
                    for (int j = 0; j < 4; ++j) {
                        const int n = n0 + sub * 16 + 4 * Q + j;
                        pr[j] = (16 * n + 31 <= qpos) ? fexp2(sv[j] - mu) * inv_lc : 0.f;
                        pr[j] += __builtin_bit_cast(float, __builtin_amdgcn_update_dpp(0, __builtin_bit_cast(int, pr[j]), 0xB1, 0xf, 0xf, true));
                        pr[j] += __builtin_bit_cast(float, __builtin_amdgcn_update_dpp(0, __builtin_bit_cast(int, pr[j]), 0x4E, 0xf, 0xf, true));
                    }
                    const float part = 2.f * (pr[0] + pr[1] + pr[2]) + pr[3];
                    const float rr = __shfl(pr[3], (lane + 48) & 63);
                    const float is = part + (Q == 0 ? rprev : rr);
                    rprev = rr;
                    if (gq == 0) imp[qi * 128 + ((n0 + sub * 16) >> 2) + Q] = is;
                }
            }, smem, tid);
    }
    wave_lds_sync();
    if (wactive) {
        const int cur = (qbase + wid * 4 + Q) >> 6;
        unsigned kk[8];
#pragma unroll
        for (int i = 0; i < 8; ++i) {
            const int blk = i * 16 + c;
            float x = imp[Q * 128 + blk];
            if (blk > cur) x = NEG_INF; else if (blk == 0 || blk == cur || blk == cur - 1) x = POS_INF;
            kk[i] = (f2ord(x) & 0xffffff80u) | (unsigned)(127 - blk);
        }
        const unsigned tk = top16_keys(kk, c);
        const int ti = 127 - (int)(tk & 127u);
        const bool finite_or_forced = (tk & 0xffffff80u) > (f2ord(NEG_INF) & 0xffffff80u);
        if (c < (SAMPLE ? 15 : 16) && finite_or_forced) atomicOr(&msk[Q * 4 + (ti >> 5)], 1u << (ti & 31));
    }
    wave_lds_sync();
    const unsigned mk0 = msk[qi * 4 + 0], mk1 = msk[qi * 4 + 1], mk2 = msk[qi * 4 + 2], mk3 = msk[qi * 4 + 3];
    unsigned wun[4];
#pragma unroll
    for (int w = 0; w < 4; ++w) wun[w] = __builtin_amdgcn_readfirstlane(msk[w] | msk[4 + w] | msk[8 + w] | msk[12 + w]);
    if (wactive && lane < 4) atomicOr(&bun[lane], lane == 0 ? wun[0] : (lane == 1 ? wun[1] : (lane == 2 ? wun[2] : wun[3])));
    __syncthreads();
    unsigned un[4];
#pragma unroll
    for (int w = 0; w < 4; ++w) un[w] = __builtin_amdgcn_readfirstlane(bun[w]);
    const int nsel = __builtin_popcount(un[0]) + __builtin_popcount(un[1]) + __builtin_popcount(un[2]) + __builtin_popcount(un[3]) + (SAMPLE ? 1 : 0);
    m = 0.f; l = 0.f;
#pragma unroll
    for (int i = 0; i < 4; ++i) o[i] = (f32x4){0.f, 0.f, 0.f, 0.f};
    {
        const BitIter keyf{un[0], un[1], un[2], un[3]};
        auto comp = [&](int, int key0, const bf16_t* kl, const bf16_t* vl) {
            if (!wactive) return;
            const int jb = key0 >> 6, w = jb >> 5, bit = jb & 31;
            const unsigned wu = w == 0 ? wun[0] : (w == 1 ? wun[1] : (w == 2 ? wun[2] : (w == 3 ? wun[3] : 1u)));
            if (!((wu >> bit) & 1u)) return;
            const unsigned mine = w == 0 ? mk0 : (w == 1 ? mk1 : (w == 2 ? mk2 : (w == 3 ? mk3 : 1u)));
            const bool mysel = (mine >> bit) & 1u;
            if (PV == 1) return;
            attn_tile64(q0, q1, kl, vl, key0, mysel, 0, qpos, m, l, o, c, Q);
        };
        if (!SAMPLE) {
            SrcBf src;
            src.K = (const bf16_t*)(ws + W_SELK) + (size_t)(b * 4 + kvh) * SEQ * 64;
            src.VT = (const bf16_t*)(ws + W_SELVT) + (size_t)(b * 4 + kvh) * 64 * SEQ;
            src.ldv = SEQ;
            coop_tiles2x(src, nsel, true, keyf, comp, smem, tid);
        } else {
            const int* pt = p.page_table + b * NPAGE;
            auto rf = [&](int tok, int which) -> const float* {
                tok = tok > PAST + 7 ? PAST + 7 : tok;
                if (tok < PAST) { const int page = pt[tok >> 7]; return p.cache_b_kv + ((size_t)(page * 128 + (tok & 127)) * 4 + 2 + which) * 256 + kvh * 64; }
                return p.out + O_BKVS + ((size_t)(b * 8 + tok - PAST) * 4 + 2 + which) * 256 + kvh * 64;
            };
            SrcF32<decltype(rf)> src{rf};
            coop_tiles(src, nsel, true, keyf, comp, Kl, VTl, tid);
        }
    }
    {
        const float ls = row_sum(l);
        const float inv = ls > 0.f ? 1.0f / ls : 0.f;
#pragma unroll
        for (int db = 0; db < 4; ++db) outacc[db] += o[db] * (g_s * inv);
    }
    m = 0.f; l = 0.f;
#pragma unroll
    for (int i = 0; i < 4; ++i) o[i] = (f32x4){0.f, 0.f, 0.f, 0.f};
    if (!SAMPLE) {
        SrcBf src;
        src.K = (const bf16_t*)(ws + W_WINK) + (size_t)(b * 4 + kvh) * SEQ * 64;
        src.VT = (const bf16_t*)(ws + W_WINVT) + (size_t)(b * 4 + kvh) * 64 * SEQ;
        src.ldv = SEQ;
        int klo = t0blk - 512; klo = klo < 0 ? 0 : klo; klo &= ~63;
        const int nws = ((t0blk + 15 - klo) >> 6) + 1;
        coop_tiles2x(src, nws, true, LinIter{klo},
            [&](int, int key0, const bf16_t* kl, const bf16_t* vl) {
                if (PV == 1) return;
                attn_tile64(q0, q1, kl, vl, key0, true, qpos - 512, qpos, m, l, o, c, Q);
            }, smem, tid);
    } else {
        auto rf = [&](int i, int which) -> const float* {
            i = i > 519 ? 519 : i;
            return i < 512 ? p.cache_b_win + ((size_t)(b * 512 + i) * 2 + which) * 256 + kvh * 64
                           : p.out + O_BWS + ((size_t)(b * 512 + i - 8) * 2 + which) * 256 + kvh * 64;
        };
        SrcF32<decltype(rf)> src{rf};
        coop_tiles(src, 9, true, LinIter{0},
            [&](int, int key0, const bf16_t* kl, const bf16_t* vl) {
                if (wactive) attn_tile64(q0, q1, kl, vl, key0, true, qpos - (PAST - 512) - 512, qpos - (PAST - 512), m, l, o, c, Q);
            }, Kl, VTl, tid);
    }
    {
        const float ls = row_sum(l);
        const float inv = ls > 0.f ? 1.0f / ls : 0.f;
#pragma unroll
        for (int db = 0; db < 4; ++db) outacc[db] += o[db] * (g_w * inv);
    }
    if (wactive) {
        bf16_t* OB = (bf16_t*)(ws + W_OB) + (size_t)trow * 1024 + hq * 64;
#pragma unroll
        for (int db = 0; db < 4; ++db) {
            u32x2 w; w.x = pk2(outacc[db][0], outacc[db][1]); w.y = pk2(outacc[db][2], outacc[db][3]);
            *(u32x2*)(OB + db * 16 + 4 * Q) = w;
        }
    }
}
template <int REP> DI void phase_nsa(const Params& p, unsigned char* smem) {
    const int tid = otid();
    unsigned* cnt = (unsigned*)(p.ws + W_CTL) + CTL_CNT_WORD + 64 * (4 + 8 * REP);
    int* sh_unit = (int*)(smem + 2 * ST2_BYTES + 288);
    const int NSU = BD * 4, NPU = NBP * 4 * 512;
    if (FLOAT_WORK && REP == 0) {
        const int nfl = (int)gridDim.x - (int)gridDim.x / 2, b0 = (int)gridDim.x / 2;
        if ((int)blockIdx.x >= b0) {
            const int bi = (int)blockIdx.x - b0;
            copy_shift_part(p.cache_a0, p.out + O_A1S, 128, 256, bi, nfl);
            copy_shift_part(p.cache_a1, p.out + O_A2S, 512, 256, bi, nfl);
            copy_shift_part(p.cache_a2, p.out + O_A3S, 2048, 256, bi, nfl);
            copy_shift_part(p.cache_b_win, p.out + O_BWS, 512, 128, bi, nfl);
        }
    }
    for (;;) {
        if (tid == 0) *sh_unit = (int)__hip_atomic_fetch_add(cnt, 1u, __ATOMIC_RELAXED, __HIP_MEMORY_SCOPE_AGENT);
        __syncthreads();
        const int u = __builtin_amdgcn_readfirstlane(*sh_unit);
        __syncthreads();
        if (u >= NSU + NPU) break;
        if (REP && PROBE_NSA_ONLY == 1 && u >= NSU) break;
        if (REP && PROBE_NSA_ONLY == 2 && u < NSU) continue;
        if (u < NSU) nsa_block_unit<true>(p, u, smem, tid); else nsa_block_unit<false, (REP ? PROBE_NSA_VARIANT : 0)>(p, u - NSU, smem, tid);
    }
}

struct SrcTiled {
    const bf16_t* K; const bf16_t* V;
    typedef TileRegsBf Regs;
    DI void load(Regs& r, int key0, int tid, bool) const {
        r.k0 = *(const bf16x8*)(K + (size_t)key0 * 64 + tid * 8); r.k1 = *(const bf16x8*)(K + (size_t)key0 * 64 + (tid + 256) * 8);
        r.v0 = *(const bf16x8*)(V + (size_t)key0 * 64 + tid * 8); r.v1 = *(const bf16x8*)(V + (size_t)key0 * 64 + (tid + 256) * 8);
    }
    DI void store(const Regs& r, bf16_t* Kl, bf16_t* Vl, int tid, bool) const {
        *(bf16x8*)&Kl[tid * 8] = r.k0; *(bf16x8*)&Kl[(tid + 256) * 8] = r.k1;
        *(bf16x8*)&Vl[tid * 8] = r.v0; *(bf16x8*)&Vl[(tid + 256) * 8] = r.v1;
    }
};
template <int NS>
DI void softmax_update(f32x4 (&s)[NS], float& m, float& l, f32x4 (&o)[4]) {
    float mx = NEG_INF;
#pragma unroll
    for (int i = 0; i < NS; ++i) mx = fmaxf(mx, fmaxf(fmaxf(s[i][0], s[i][1]), fmaxf(s[i][2], s[i][3])));
    if (__any(mx > LAZY_T)) {
        float mr = mx + m;
        mr = fmaxf(mr, __shfl_xor(mr, 16)); mr = fmaxf(mr, __shfl_xor(mr, 32));
        const float mn = fmaxf(m, mr), shift = mn - m, alpha = fexp2(-shift);
        l *= alpha; m = mn;
#pragma unroll
        for (int db = 0; db < 4; ++db) o[db] = o[db] * alpha;
#pragma unroll
        for (int i = 0; i < NS; ++i)
#pragma unroll
            for (int j = 0; j < 4; ++j) s[i][j] -= shift;
    }
#pragma unroll
    for (int i = 0; i < NS; ++i)
#pragma unroll
        for (int j = 0; j < 4; ++j) { s[i][j] = fexp2(s[i][j]); l += s[i][j]; }
}
DI void attn_tile64_tiled(const bf16x8& q0, const bf16x8& q1, const bf16_t* Kl, const bf16_t* Vl, int key0, int klo, int khi,
                          float& m, float& l, f32x4 (&o)[4], int lane) {
    const int Q = lane >> 4;
    f32x4 s[4];
#pragma unroll
    for (int sub = 0; sub < 4; ++sub) {
        s[sub] = (f32x4){-m, -m, -m, -m};
        s[sub] = MFMA16(*(const bf16x8*)&Kl[((sub * 2 + 0) * 64 + lane) * 8], q0, s[sub]);
        s[sub] = MFMA16(*(const bf16x8*)&Kl[((sub * 2 + 1) * 64 + lane) * 8], q1, s[sub]);
    }
    if (__any(key0 < klo || key0 + 63 > khi)) {
        const unsigned span = (unsigned)(khi - klo);
        const int kb = key0 + 4 * Q - klo;
#pragma unroll
        for (int sub = 0; sub < 4; ++sub)
#pragma unroll
            for (int j = 0; j < 4; ++j) if ((unsigned)(kb + sub * 16 + j) > span) s[sub][j] = NEG_INF;
    }
    softmax_update<4>(s, m, l, o);
#pragma unroll
    for (int half = 0; half < 2; ++half) {
        const bf16x8 pb = pack8(s[2 * half][0], s[2 * half][1], s[2 * half][2], s[2 * half][3], s[2 * half + 1][0], s[2 * half + 1][1], s[2 * half + 1][2], s[2 * half + 1][3]);
#pragma unroll
        for (int db = 0; db < 4; ++db) o[db] = MFMA16(*(const bf16x8*)&Vl[((half * 4 + db) * 64 + lane) * 8], pb, o[db]);
    }
}
DI void attn_tile32_regs0(const bf16x8& q0, const bf16x8& q1, const KVregs& F, int key0, int klo, int khi, float& m, float& l, f32x4 (&o)[4], int Q) {
    f32x4 s[2];
    s[0] = (f32x4){-m, -m, -m, -m}; s[1] = s[0];
    s[0] = MFMA16(F.k[0], q0, s[0]); s[0] = MFMA16(F.k[1], q1, s[0]);
    s[1] = MFMA16(F.k[2], q0, s[1]); s[1] = MFMA16(F.k[3], q1, s[1]);
    {
        const unsigned span = (unsigned)(khi - klo);
        const int kb = key0 + 4 * Q - klo;
#pragma unroll
        for (int sub = 0; sub < 2; ++sub)
#pragma unroll
            for (int j = 0; j < 4; ++j) if ((unsigned)(kb + sub * 16 + j) > span) s[sub][j] = NEG_INF;
    }
    softmax_update<2>(s, m, l, o);
    const bf16x8 pb = pack8(s[0][0], s[0][1], s[0][2], s[0][3], s[1][0], s[1][1], s[1][2], s[1][3]);
    o[0] = MFMA16(F.v[0], pb, o[0]); o[1] = MFMA16(F.v[1], pb, o[1]); o[2] = MFMA16(F.v[2], pb, o[2]); o[3] = MFMA16(F.v[3], pb, o[3]);
}
DI void attnA_prompt_block(const Params& p, int u, unsigned char* smem, int tid) {
    const int lane = tid & 63, wid = tid >> 6, c = lane & 15, Q = lane >> 4;
    const int r0 = u & 3, tb = (u >> 2) & 31, head = (u >> 7) & 7, b = u >> 10;
    const int r = r0 + 4 * wid;
    const int trow = b * SEQ + tb * 256 + r + 16 * c;
    const bf16_t* QA = (const bf16_t*)(p.ws + W_QA) + (size_t)trow * 1536 + head * 64 + Q * 8;
    float m = 0.f, l = 0.f; f32x4 o[4];
#pragma unroll
    for (int i = 0; i < 4; ++i) o[i] = (f32x4){0.f, 0.f, 0.f, 0.f};
    {
        const bf16x8 q0 = *(const bf16x8*)(QA), q1 = *(const bf16x8*)(QA + 32);
        SrcTiled src;
        src.K = (const bf16_t*)(p.ws + W_KA) + (size_t)((0 * 2 + b) * 8 + head) * SEQ * 64;
        src.V = (const bf16_t*)(p.ws + W_VAT) + (size_t)((0 * 2 + b) * 8 + head) * SEQ * 64;
        const int mi = tb * 256 + r + 16 * c;
        int lo = tb * 256 + r0 - 128; lo = lo < 0 ? 0 : lo; lo &= ~63;
        const int hi = tb * 256 + r0 + 12 + 240;
        const int wlo = tb * 256 + r - 128, whi = tb * 256 + r + 240;
        coop_tiles2x(src, ((hi - lo) >> 6) + 1, true, LinIter{lo},
            [&](int, int key0, const bf16_t* kl, const bf16_t* vl) {
                if (key0 + 63 < wlo || key0 > whi) return;
                attn_tile64_tiled(q0, q1, kl, vl, key0, mi - 128, mi, m, l, o, lane);
            }, smem, tid);
    }
    {
        const bf16x8 q0 = *(const bf16x8*)(QA + 512), q1 = *(const bf16x8*)(QA + 512 + 32);
        constexpr int L = SEQ >> 2;
        SrcTiled src;
        src.K = (const bf16_t*)(p.ws + W_KA) + ((size_t)((1 * 2 + b) * 8 + head) * SEQ + (size_t)r0 * L) * 64;
        src.V = (const bf16_t*)(p.ws + W_VAT) + ((size_t)((1 * 2 + b) * 8 + head) * SEQ + (size_t)r0 * L) * 64;
        const int mq0 = tb * 64 + wid, mi = mq0 + 4 * c;
        int lo = tb * 64 - 128; lo = lo < 0 ? 0 : lo; lo &= ~63;
        const int hi = tb * 64 + 3 + 60;
        coop_tiles2x(src, ((hi - lo) >> 6) + 1, true, LinIter{lo},
            [&](int, int key0, const bf16_t* kl, const bf16_t* vl) {
                if (key0 + 63 < mq0 - 128 || key0 > mq0 + 60) return;
                attn_tile64_tiled(q0, q1, kl, vl, key0, mi - 128, mi, m, l, o, lane);
            }, smem, tid);
    }
    {
        const bf16x8 q0 = *(const bf16x8*)(QA + 1024), q1 = *(const bf16x8*)(QA + 1024 + 32);
        constexpr int L = SEQ >> 4;
        KVtiled kv;
        kv.K = (const bf16_t*)(p.ws + W_KA) + ((size_t)((2 * 2 + b) * 8 + head) * SEQ + (size_t)r * L) * 64;
        kv.VT = (const bf16_t*)(p.ws + W_VAT) + ((size_t)((2 * 2 + b) * 8 + head) * SEQ + (size_t)r * L) * 64;
        kv.lane = lane;
        const int mq0 = tb * 16, mi = mq0 + c;
        int klo = mq0 - 128; klo = klo < 0 ? 0 : klo; klo &= ~31;
        const int khi = mq0 + 15;
        KVregs F0, F1;
        F0.load(kv, klo);
        for (int key0 = klo; key0 <= khi; key0 += 64) {
            const bool has1 = key0 + 32 <= khi;
            if (has1) F1.load(kv, key0 + 32);
            attn_tile32_regs0(q0, q1, F0, key0, mi - 128, mi, m, l, o, Q);
            if (has1) {
                if (key0 + 64 <= khi) F0.load(kv, key0 + 64);
                attn_tile32_regs0(q0, q1, F1, key0 + 32, mi - 128, mi, m, l, o, Q);
            }
        }
    }
    const float inv = 1.0f / row_sum(l);
    bf16_t* OA = (bf16_t*)(p.ws + W_OA) + (size_t)trow * 512 + head * 64;
#pragma unroll
    for (int db = 0; db < 4; ++db) {
        u32x2 w; w.x = pk2(o[db][0] * inv, o[db][1] * inv); w.y = pk2(o[db][2] * inv, o[db][3] * inv);
        *(u32x2*)(OA + db * 16 + 4 * Q) = w;
    }
}
template <int REP> DI void phase_attnA2(const Params& p, unsigned char* smem) {
    const int tid = otid();
    int* sh_unit = (int*)(smem + 2 * ST2_BYTES + 288);
    unsigned* cnts = (unsigned*)(p.ws + W_CTL) + CTL_CNT_WORD + 64 * (7 + 8 * REP);
    unsigned* cntp = (unsigned*)(p.ws + W_CTL) + CTL_CNT_WORD + 64 * (0 + 8 * REP);
    if (FLOAT_WORK && REP == 0) {
        const int nfl = (int)gridDim.x - (int)gridDim.x / 2, b0 = (int)gridDim.x / 2;
        if ((int)blockIdx.x >= b0) {
            unsigned char* ws = p.ws;
            const int bi = (int)blockIdx.x - b0;
            quant_rows_part(p.peer_u, ws + W_U8, (float*)(ws + W_SU), NEXP, p.g_ffn, bi, nfl);
            quant_rows_part(p.peer_u + (size_t)NEXP * 1024, ws + W_U8 + (size_t)NEXP * 1024, (float*)(ws + W_SU) + NEXP, NEXP, p.g_ffn + D, bi, nfl);
            quant_rows_part(p.peer_v, ws + W_V8, (float*)(ws + W_SV), 2 * NEXP, nullptr, bi, nfl);
        }
    }
    for (int pass = 0; pass < 2; ++pass) {
        const int nunits = pass == 0 ? BD * 8 : NBP * 8 * 32 * 4;
        for (;;) {
            if (tid == 0) *sh_unit = (int)__hip_atomic_fetch_add(pass == 0 ? cnts : cntp, 1u, __ATOMIC_RELAXED, __HIP_MEMORY_SCOPE_AGENT);
            __syncthreads();
            const int u = __builtin_amdgcn_readfirstlane(*sh_unit);
            __syncthreads();
            if (u >= nunits) break;
            if (pass == 0) attnA_sample_block(p, u, smem, tid); else attnA_prompt_block(p, u, smem, tid);
        }
    }
}

template <int PH, int REP = 0> DI void run_phase(const Params& p, unsigned char* smem) {
    unsigned char* ws = p.ws;
    const float* XRf = (const float*)(ws + W_XR);
    if (PH == 0) phase_prologue<(REP ? PROBE_P0_VARIANT : 0)>(p, smem);
    else if (PH == 1) gemm_run_i8<1>(p, ws + W_XQ, (const float*)(ws + W_SA), ws + W_WTIN, (const float*)(ws + W_SWIN), N_IN / 128, smem);
    else if (PH == 2) phase_attnA2<REP>(p, smem);
    else if (PH == 3) gemm_run<3>(p, (const bf16_t*)(ws + W_OA), (const bf16_t*)(ws + W_WTOA), 512, 1024 / 128, smem);
    else if (PH == 4) norm_rows_q8(XRf, XRf + (size_t)MP * D, ws + W_XQ, (float*)(ws + W_SA));
    else if (PH == 5) gemm_run_i8<5>(p, ws + W_XQ, (const float*)(ws + W_SA), ws + W_WTPQ, (const float*)(ws + W_SWPQ), N_PQ / 128, smem);
    else if (PH == 6) phase_peerA<0, REP>(p, smem);
    else if (PH == 7) phase_peerB<0, REP>(p, smem);
    else if (PH == 8) gemm_run_i8<8>(p, ws + W_XQ, (const float*)(ws + W_SA), ws + W_WTKVQG, (const float*)(ws + W_SWKV), N_KVQG / 128, smem);
    else if (PH == 9) phase_compress<REP>(p, smem);
    else if (PH == 10) phase_nsa<REP>(p, smem);
    else if (PH == 11) gemm_run<11>(p, (const bf16_t*)(ws + W_OB), (const bf16_t*)(ws + W_WTOB), 1024, 1024 / 128, smem);
    else if (PH == 12) norm_rows_q8(XRf, XRf + (size_t)MP * D, ws + W_XQ, (float*)(ws + W_SA));
    else if (PH == 13) gemm_run_i8<6>(p, ws + W_XQ, (const float*)(ws + W_SA), ws + W_WTPQ + (size_t)N_PQ * 1024, (const float*)(ws + W_SWPQ) + N_PQ, N_PQ / 128, smem);
    else if (PH == 14) phase_peerA<1, REP>(p, smem);
    else if (PH == 15) phase_peerB<1, REP>(p, smem);
}
constexpr int NPHASE = 16;

#if FUSED
__global__ void __launch_bounds__(NTHREADS, 2) yoco_fwd(Params p) {
    __shared__ __attribute__((aligned(16))) unsigned char smem[SMEM_BYTES];
    __shared__ uint4 xb_words;
    if (threadIdx.x == 0) xb_words = make_uint4(0u, 0u, 0u, 0u);
    __syncthreads();
    XcdBarrier bar = xcd_barrier_post((unsigned*)(p.ws + W_CTL), (volatile LAS unsigned*)&xb_words);
#define PHX(i) do { if (PROBE_DUP & (1 << (i))) { run_phase<i, 1>(p, smem); xcd_barrier(bar); } run_phase<i, 0>(p, smem); if ((i) < NPHASE - 1) xcd_barrier(bar); } while (0)
    PHX(0); PHX(1); PHX(2); PHX(3); PHX(4); PHX(5); PHX(6); PHX(7); PHX(8); PHX(9); PHX(10); PHX(11); PHX(12); PHX(13); PHX(14); PHX(15);
}
#else
template <int PH> __global__ void __launch_bounds__(NTHREADS, 2) yoco_phase(Params p) {
    __shared__ __attribute__((aligned(16))) unsigned char smem[SMEM_BYTES];
    run_phase<PH>(p, smem);
}
#endif

extern "C" void kernel_launch(void* const* d_in, const int* in_sizes, int n_in, void* d_out, int out_size, void* d_ws, size_t ws_size, hipStream_t stream) {
    (void)in_sizes; (void)n_in; (void)out_size; (void)ws_size;
    Params p{};
    p.x_prompt = (const float*)d_in[0]; p.x_sample = (const float*)d_in[1];
    p.cache_a0 = (const float*)d_in[2]; p.cache_a1 = (const float*)d_in[3]; p.cache_a2 = (const float*)d_in[4];
    p.cache_b_kv = (const float*)d_in[5]; p.cache_b_win = (const float*)d_in[6]; p.page_table = (const int*)d_in[7];
    p.g_mix = (const float*)d_in[8]; p.g_ffn = (const float*)d_in[9]; p.w_in_a = (const float*)d_in[10]; p.w_o_a = (const float*)d_in[11];
    p.g_kv = (const float*)d_in[12]; p.w_kv_b = (const float*)d_in[13]; p.w_cmp1 = (const float*)d_in[14]; p.w_cmp2 = (const float*)d_in[15];
    p.pe_cmp = (const float*)d_in[16]; p.w_qg_b = (const float*)d_in[17]; p.b_gate_b = (const float*)d_in[18]; p.w_o_b = (const float*)d_in[19];
    p.w_peer_q = (const float*)d_in[20]; p.peer_subkeys = (const float*)d_in[21]; p.peer_u = (const float*)d_in[22]; p.peer_v = (const float*)d_in[23];
    p.g_final = (const float*)d_in[24];
    p.out = (float*)d_out; p.ws = (unsigned char*)d_ws;
    hipMemsetAsync(d_ws, 0, 262144, stream);
#if FUSED
    static int grid = 0;
    if (!grid) {
        int dev = 0, cus = 0, per_cu = 0;
        hipGetDevice(&dev);
        hipDeviceGetAttribute(&cus, hipDeviceAttributeMultiprocessorCount, dev);
        hipOccupancyMaxActiveBlocksPerMultiprocessor(&per_cu, (const void*)yoco_fwd, NTHREADS, 0);
        int use = per_cu < 2 ? per_cu : 2; if (use < 1) use = 1;
        grid = cus * use;
    }
    hipLaunchKernelGGL(yoco_fwd, dim3(grid), dim3(NTHREADS), 0, stream, p);
#else
    const int grid = 512;
#define LAUNCH_PH(i) hipLaunchKernelGGL(yoco_phase<i>, dim3(grid), dim3(NTHREADS), 0, stream, p)
    LAUNCH_PH(0); LAUNCH_PH(1); LAUNCH_PH(2); LAUNCH_PH(3); LAUNCH_PH(4); LAUNCH_PH(5); LAUNCH_PH(6);
    LAUNCH_PH(7); LAUNCH_PH(8); LAUNCH_PH(9); LAUNCH_PH(10); LAUNCH_PH(11); LAUNCH_PH(12); LAUNCH_PH(13); LAUNCH_PH(14); LAUNCH_PH(15);
#endif
}
```

```cpp
#include <hip/hip_runtime.h>
#include <stdint.h>
#include <stdio.h>

#ifndef FUSED
#define FUSED 1
#define FLOAT_WORK 1
#endif
#ifndef PROBE_NSA_ONLY
#define PROBE_NSA_ONLY 0
#endif
#ifndef PROBE_NSA_VARIANT
#define PROBE_NSA_VARIANT 0
#endif
#ifndef PROBE_P0_VARIANT
#define PROBE_P0_VARIANT 0
#endif
#ifndef PROBE_DUP
#define PROBE_DUP 0
#endif

typedef unsigned short bf16_t;
typedef short bf16x8 __attribute__((ext_vector_type(8)));
typedef short bf16x4 __attribute__((ext_vector_type(4)));
typedef float f32x4 __attribute__((ext_vector_type(4)));
typedef unsigned u32x4 __attribute__((ext_vector_type(4)));
typedef unsigned u32x2 __attribute__((ext_vector_type(2)));
#define DI __device__ __forceinline__
#define MFMA16(a, b, c) __builtin_amdgcn_mfma_f32_16x16x32_bf16((a), (b), (c), 0, 0, 0)
typedef int i32x4 __attribute__((ext_vector_type(4)));
#define MFMA_I8(a, b, c) __builtin_amdgcn_mfma_i32_16x16x64_i8((a), (b), (c), 0, 0, 0)
#define NEG_INF (-__builtin_inff())
#define POS_INF (__builtin_inff())

constexpr int D = 1024, SEQ = 8192, NBP = 2, MP = NBP * SEQ, BD = 32, SD = 8, MS = BD * SD, M = MP + MS;
constexpr int PAST = 8192, NPAGE = 64;
constexpr int N_IN = 4608, N_PQ = 2048, N_KVQG = 2688, N_KV = 1536;
constexpr int NEXP = 16384;
constexpr float QSCALE = 0.18033688011112042f;

constexpr size_t O_YP = 0;
constexpr size_t O_YS = O_YP + (size_t)MP * D;
constexpr size_t O_A1P = O_YS + (size_t)MS * D;
constexpr size_t O_A1S = O_A1P + (size_t)NBP * 128 * 1024;
constexpr size_t O_A2P = O_A1S + (size_t)BD * 128 * 1024;
constexpr size_t O_A2S = O_A2P + (size_t)NBP * 512 * 1024;
constexpr size_t O_A3P = O_A2S + (size_t)BD * 512 * 1024;
constexpr size_t O_A3S = O_A3P + (size_t)NBP * 2048 * 1024;
constexpr size_t O_BKVP = O_A3S + (size_t)BD * 2048 * 1024;
constexpr size_t O_BKVS = O_BKVP + (size_t)MP * 1024;
constexpr size_t O_BWP = O_BKVS + (size_t)MS * 1024;
constexpr size_t O_BWS = O_BWP + (size_t)NBP * 512 * 512;
constexpr size_t O_END = O_BWS + (size_t)BD * 512 * 512;

constexpr size_t al256(size_t x) { return (x + 255) & ~(size_t)255; }
constexpr size_t W_CTL = 0;
constexpr size_t W_ROWSS = 65536;
constexpr size_t W_CMIN = 200704;
constexpr size_t W_CMKV = W_CMIN + (size_t)N_IN * 4;
constexpr size_t W_WTIN = 262144;
constexpr size_t W_WTOA = W_WTIN + al256((size_t)N_IN * 1024 * 2);
constexpr size_t W_WTPQ = W_WTOA + al256((size_t)1024 * 512 * 2);
constexpr size_t W_WTKVQG = W_WTPQ + al256((size_t)2 * N_PQ * 1024 * 2);
constexpr size_t W_WTOB = W_WTKVQG + al256((size_t)N_KVQG * 1024 * 2);
constexpr size_t W_SUBK = W_WTOB + al256((size_t)1024 * 1024 * 2);
constexpr size_t W_U8 = W_SUBK + al256((size_t)2 * 2 * 128 * 128 * 2);
constexpr size_t W_V8 = W_U8 + al256((size_t)2 * NEXP * 1024);
constexpr size_t W_SU = W_V8 + al256((size_t)2 * NEXP * 1024);
constexpr size_t W_SV = W_SU + al256((size_t)2 * NEXP * 4);
constexpr size_t W_WC1 = W_SV + al256((size_t)2 * NEXP * 4);
constexpr size_t W_WC2 = W_WC1 + al256((size_t)2 * 64 * 2048 * 2);
constexpr size_t W_PET = W_WC2 + al256((size_t)2 * 64 * 64 * 2);
constexpr size_t W_ROPE = W_PET + al256((size_t)2 * 64 * 4);
constexpr size_t W_XHAT = W_ROPE + al256((size_t)8200 * 8 * 2 * 4);
constexpr size_t W_XR = W_XHAT + al256((size_t)M * 1024 * 2);
constexpr size_t W_QA = W_XR + al256((size_t)M * 1024 * 4);
constexpr size_t W_KA = W_QA + al256((size_t)M * 1536 * 2);
constexpr size_t W_VAT = W_KA + al256((size_t)3 * 2 * 8 * 8192 * 64 * 2);
constexpr size_t W_OA = W_VAT + al256((size_t)3 * 2 * 8 * 8192 * 64 * 2);
constexpr size_t W_QH = W_OA + al256((size_t)M * 512 * 2);
constexpr size_t W_CMPK = W_QH + al256((size_t)M * 2048 * 2);
constexpr size_t W_CMPV = W_CMPK + al256((size_t)2 * 8192 * 256 * 2);
constexpr size_t W_SELK = W_CMPV + al256((size_t)2 * 8192 * 256 * 2);
constexpr size_t W_SELVT = W_SELK + al256((size_t)2 * 8192 * 256 * 2);
constexpr size_t W_WINK = W_SELVT + al256((size_t)2 * 8192 * 256 * 2);
constexpr size_t W_WINVT = W_WINK + al256((size_t)2 * 8192 * 256 * 2);
constexpr size_t W_QB = W_WINVT + al256((size_t)2 * 8192 * 256 * 2);
constexpr size_t W_GATE = W_QB + al256((size_t)M * 1024 * 2);
constexpr size_t W_KC = W_GATE + al256((size_t)M * 48 * 4);
constexpr size_t W_VCT = W_KC + al256((size_t)34 * 4 * 512 * 64 * 2);
constexpr size_t W_OB = W_VCT + al256((size_t)34 * 4 * 512 * 64 * 2);
constexpr size_t W_SELE = W_OB + al256((size_t)M * 1024 * 2);
constexpr size_t W_SELG = W_SELE + al256((size_t)M * 128 * 2);
constexpr size_t W_SELU = W_SELG + al256((size_t)M * 128 * 4);
constexpr size_t W_XQ = W_SELU + al256((size_t)M * 128 * 4);
constexpr size_t W_SA = W_XQ + al256((size_t)M * 1024);
constexpr size_t W_SWIN = W_SA + al256((size_t)M * 4);
constexpr size_t W_SWKV = W_SWIN + al256((size_t)N_IN * 4);
constexpr size_t W_SWPQ = W_SWKV + al256((size_t)N_KVQG * 4);
constexpr size_t W_END = W_SWPQ + al256((size_t)2 * N_PQ * 4);

constexpr int CTL_CNT_WORD = 4096;
constexpr int NTHREADS = 256;
constexpr int SMEM_BYTES = 74240;

struct Params {
    const float* x_prompt; const float* x_sample; const float* cache_a0; const float* cache_a1; const float* cache_a2;
    const float* cache_b_kv; const float* cache_b_win; const int* page_table;
    const float* g_mix; const float* g_ffn; const float* w_in_a; const float* w_o_a; const float* g_kv; const float* w_kv_b;
    const float* w_cmp1; const float* w_cmp2; const float* pe_cmp; const float* w_qg_b; const float* b_gate_b; const float* w_o_b;
    const float* w_peer_q; const float* peer_subkeys; const float* peer_u; const float* peer_v; const float* g_final;
    float* out; unsigned char* ws;
};

typedef __bf16 bf16v2 __attribute__((ext_vector_type(2)));
typedef float f32v2 __attribute__((ext_vector_type(2)));
DI unsigned pk2(float a, float b) { const f32v2 v = {a, b}; return __builtin_bit_cast(unsigned, __builtin_convertvector(v, bf16v2)); }
DI unsigned f2bf(float x) { return pk2(x, 0.f) & 0xffffu; }
DI float bf2f(unsigned h) { return __uint_as_float(h << 16); }
DI bf16x8 pack8(float a0, float a1, float a2, float a3, float a4, float a5, float a6, float a7) {
    u32x4 u; u.x = pk2(a0, a1); u.y = pk2(a2, a3); u.z = pk2(a4, a5); u.w = pk2(a6, a7); return __builtin_bit_cast(bf16x8, u);
}
DI float fexp2(float x) { return __builtin_amdgcn_exp2f(x); }
DI float gelu_tanh(float x) {
    const float y = 0.7978845608028654f * (x + 0.044715f * x * x * x);
    const float e = __expf(2.0f * y);
    const float t = 1.0f - 2.0f / (e + 1.0f);
    return 0.5f * x * (1.0f + t);
}
DI int otid() { int t = threadIdx.x; asm volatile("" : "+v"(t)); return t; }
DI int pos_of_row(int row) { return row < MP ? (row & (SEQ - 1)) : PAST + ((row - MP) & 7); }
DI void wave_lds_sync() { asm volatile("s_waitcnt lgkmcnt(0)" ::: "memory"); __builtin_amdgcn_wave_barrier(); asm volatile("" ::: "memory"); }
DI void lds_barrier() { asm volatile("s_waitcnt lgkmcnt(0)" ::: "memory"); __builtin_amdgcn_s_barrier(); asm volatile("" ::: "memory"); }
DI float wave_sum(float v) {
#pragma unroll
    for (int off = 32; off >= 1; off >>= 1) v += __shfl_xor(v, off);
    return v;
}

#define XB_TMO      128
#define XB_XCNT(j)  (256  + 64 * (j))
#define XB_XSUB(j)  (1280 + 64 * (j))
#define XB_XGEN(j)  (2304 + 64 * (j))
#define XB_TOP      3328
#define XB_TOPGEN   3392
#define XCD_BAR_WORDS 3456
#define XB_SPIN_CAP (1u << 22)
#define LAS __attribute__((address_space(3)))

__device__ __forceinline__ unsigned xb_ld(unsigned* p)              { return __hip_atomic_load(p, __ATOMIC_RELAXED, __HIP_MEMORY_SCOPE_AGENT); }
__device__ __forceinline__ unsigned xb_add(unsigned* p, unsigned v) { return __hip_atomic_fetch_add(p, v, __ATOMIC_RELAXED, __HIP_MEMORY_SCOPE_AGENT); }
__device__ __forceinline__ unsigned xb_xcc_id() { return (unsigned)__builtin_amdgcn_s_getreg((3 << 11) | 20) & 0xFu; }
#define XB_SPIN(cond, bar) do { unsigned _sp = 0; while (cond) { __builtin_amdgcn_s_sleep(1); \
    if ((++_sp & 255u) == 0u) { if (xb_ld(&(bar)[XB_TMO])) break; if (_sp > XB_SPIN_CAP) { atomicAdd(&(bar)[XB_TMO], 1u); break; } } } } while (0)

struct XcdBarrier { unsigned* bar; unsigned x; volatile LAS unsigned* st; };

__device__ __forceinline__ XcdBarrier xcd_barrier_post(unsigned* bar, volatile LAS unsigned* st) {
    XcdBarrier b; b.bar = bar; b.x = xb_xcc_id(); b.st = st;
    if (threadIdx.x == 0) (void)xb_add(&bar[XB_XCNT(b.x)], 1u);
    return b;
}
__device__ __forceinline__ void xcd_barrier_complete(unsigned* bar, unsigned x, unsigned& nloc, unsigned& nx) {
    const unsigned G = gridDim.x * gridDim.y * gridDim.z;
    unsigned sum, cnt, mine, sp = 0u;
    for (;;) {
        sum = 0u; cnt = 0u; mine = 0u;
#pragma unroll
        for (unsigned j = 0; j < 16; ++j) { const unsigned c = xb_ld(&bar[XB_XCNT(j)]); sum += c; cnt += (c > 0u) ? 1u : 0u; mine = (j == x) ? c : mine; }
        if (sum == G) break;
        __builtin_amdgcn_s_sleep(1);
        if ((++sp & 255u) == 0u) { if (xb_ld(&bar[XB_TMO])) break; if (sp > XB_SPIN_CAP) { atomicAdd(&bar[XB_TMO], 1u); break; } }
    }
    nloc = mine > 0u ? mine : 1u; nx = cnt > 0u ? cnt : 1u;
}
__device__ __forceinline__ void xcd_barrier(const XcdBarrier& b) {
    asm volatile("s_waitcnt vmcnt(0)" ::: "memory");
    __syncthreads();
    if (threadIdx.x == 0) {
        unsigned* bar = b.bar;
        __builtin_amdgcn_s_waitcnt(0);
        unsigned nloc = b.st[0], nx = b.st[1];
        if (nloc == 0u) { xcd_barrier_complete(bar, b.x, nloc, nx); b.st[0] = nloc; b.st[1] = nx; }
        const unsigned old = xb_add(&bar[XB_XSUB(b.x)], 1u);
        const unsigned gen = old / nloc;
        if (old + 1u == (gen + 1u) * nloc) {
            __builtin_amdgcn_fence(__ATOMIC_RELEASE, "agent");
            asm volatile("s_waitcnt vmcnt(0)" ::: "memory");
            const unsigned og = xb_add(&bar[XB_TOP], 1u);
            const unsigned tg = og / nx;
            if (og + 1u == (tg + 1u) * nx) xb_add(&bar[XB_TOPGEN], 1u);
            else XB_SPIN(xb_ld(&bar[XB_TOPGEN]) == tg, bar);
            __builtin_amdgcn_fence(__ATOMIC_ACQUIRE, "agent");
            xb_add(&bar[XB_XGEN(b.x)], 1u);
            asm volatile("s_waitcnt vmcnt(0)" ::: "memory");
        } else {
            XB_SPIN(xb_ld(&bar[XB_XGEN(b.x)]) == gen, bar);
            __builtin_amdgcn_fence(__ATOMIC_ACQUIRE, "agent");
            asm volatile("s_waitcnt vmcnt(0)" ::: "memory");
        }
    }
    __syncthreads();
}

DI int wave_next(unsigned* cnt, int lane) {
    int u = 0;
    if (lane == 0) u = (int)__hip_atomic_fetch_add(cnt, 1u, __ATOMIC_RELAXED, __HIP_MEMORY_SCOPE_AGENT);
    return __builtin_amdgcn_readfirstlane(u);
}

DI void transpose_cvt(const float* __restrict__ W, int K, int N, bf16_t* __restrict__ Wt, const float* __restrict__ gain, float* tile) {
    const int ntk = K >> 6, ntn = (N + 63) >> 6, tid = otid();
    for (int t = blockIdx.x; t < ntk * ntn; t += gridDim.x) {
        const int tk = t / ntn, tn = t - tk * ntn;
        float4 v[4];
#pragma unroll
        for (int i = 0; i < 4; ++i) {
            const int id = tid + 256 * i, kr = id >> 4, n4 = (id & 15) * 4;
            const int k = tk * 64 + kr, n = tn * 64 + n4;
            v[i] = (n < N) ? *(const float4*)(W + (size_t)k * N + n) : make_float4(0.f, 0.f, 0.f, 0.f);
            if (gain) { const float g = gain[k]; v[i].x *= g; v[i].y *= g; v[i].z *= g; v[i].w *= g; }
        }
#pragma unroll
        for (int i = 0; i < 4; ++i) {
            const int id = tid + 256 * i, kr = id >> 4, n4 = (id & 15) * 4;
            tile[(n4 + 0) * 65 + kr] = v[i].x; tile[(n4 + 1) * 65 + kr] = v[i].y; tile[(n4 + 2) * 65 + kr] = v[i].z; tile[(n4 + 3) * 65 + kr] = v[i].w;
        }
        __syncthreads();
#pragma unroll
        for (int i = 0; i < 2; ++i) {
            const int id = tid + 256 * i, nr = id >> 3, k8 = (id & 7) * 8;
            const int n = tn * 64 + nr;
            if (n < N) {
                const float* tp = tile + nr * 65 + k8;
                u32x4 o; o.x = pk2(tp[0], tp[1]); o.y = pk2(tp[2], tp[3]); o.z = pk2(tp[4], tp[5]); o.w = pk2(tp[6], tp[7]);
                *(u32x4*)(Wt + (size_t)n * K + tk * 64 + k8) = o;
            }
        }
        __syncthreads();
    }
}
DI void colmax_pass(const float* __restrict__ W, int K, int N, const float* __restrict__ gain, unsigned* __restrict__ cm) {
    const int ncg = (N + 255) >> 8, nkc = K >> 6, tid = otid();
    for (int u = blockIdx.x; u < ncg * nkc; u += gridDim.x) {
        const int kc = u / ncg, n = (u - kc * ncg) * 256 + tid;
        if (n < N) {
            float m = 0.f;
#pragma unroll 8
            for (int k = kc * 64; k < kc * 64 + 64; ++k) m = fmaxf(m, fabsf(W[(size_t)k * N + n] * gain[k]));
            atomicMax(cm + n, __float_as_uint(m));
        }
    }
}
DI void transpose_q8(const float* __restrict__ W, int K, int N, unsigned char* __restrict__ Wq, float* __restrict__ sw, const float* __restrict__ gain,
                     const unsigned* __restrict__ cm, float* tile) {
    const int ntk = K >> 6, ntn = (N + 63) >> 6, tid = otid();
    for (int t = blockIdx.x; t < ntk * ntn; t += gridDim.x) {
        const int tk = t / ntn, tn = t - tk * ntn;
        float4 v[4];
#pragma unroll
        for (int i = 0; i < 4; ++i) {
            const int id = tid + 256 * i, kr = id >> 4, n4 = (id & 15) * 4;
            const int k = tk * 64 + kr, n = tn * 64 + n4;
            v[i] = (n < N) ? *(const float4*)(W + (size_t)k * N + n) : make_float4(0.f, 0.f, 0.f, 0.f);
            const float g = gain[k]; v[i].x *= g; v[i].y *= g; v[i].z *= g; v[i].w *= g;
        }
#pragma unroll
        for (int i = 0; i < 4; ++i) {
            const int id = tid + 256 * i, kr = id >> 4, n4 = (id & 15) * 4;
            tile[(n4 + 0) * 65 + kr] = v[i].x; tile[(n4 + 1) * 65 + kr] = v[i].y; tile[(n4 + 2) * 65 + kr] = v[i].z; tile[(n4 + 3) * 65 + kr] = v[i].w;
        }
        __syncthreads();
        {
            const int nr = tid >> 2, k16 = (tid & 3) * 16, n = tn * 64 + nr;
            if (n < N) {
                const float cmx = __uint_as_float(cm[n]);
                const float inv = cmx > 0.f ? 127.0f / cmx : 0.f;
                const float* tp = tile + nr * 65 + k16;
                u32x4 o;
#pragma unroll
                for (int i = 0; i < 4; ++i) {
                    const int a = (int)rintf(tp[4 * i] * inv), b = (int)rintf(tp[4 * i + 1] * inv), c2 = (int)rintf(tp[4 * i + 2] * inv), d = (int)rintf(tp[4 * i + 3] * inv);
                    o[i] = (unsigned)(a & 255) | ((unsigned)(b & 255) << 8) | ((unsigned)(c2 & 255) << 16) | ((unsigned)(d & 255) << 24);
                }
                *(u32x4*)(Wq + (size_t)n * K + tk * 64 + k16) = o;
                if (tk == 0 && k16 == 0) sw[n] = cmx > 0.f ? cmx * (1.0f / 127.0f) : 1.0f;
            }
        }
        __syncthreads();
    }
}
DI void quant_weight_strips(const float* __restrict__ W, int N, unsigned char* __restrict__ Wq, float* __restrict__ sw, const float* __restrict__ gain, float* tile) {
    constexpr int K = 1024, TP = 1028;
    const int tid = otid();
    for (int u = blockIdx.x; u < (N >> 4); u += gridDim.x) {
        const int n0 = u * 16;
#pragma unroll 4
        for (int i = 0; i < 16; ++i) {
            const int id = tid + 256 * i, k = id >> 2, part = id & 3;
            float4 v = *(const float4*)(W + (size_t)k * N + n0 + part * 4);
            const float g = gain[k];
            tile[(part * 4 + 0) * TP + k] = v.x * g; tile[(part * 4 + 1) * TP + k] = v.y * g; tile[(part * 4 + 2) * TP + k] = v.z * g; tile[(part * 4 + 3) * TP + k] = v.w * g;
        }
        __syncthreads();
        {
            const int n = tid >> 4, l16 = tid & 15;
            const float* tp = tile + n * TP + l16 * 64;
            float am = 0.f;
#pragma unroll 8
            for (int i = 0; i < 64; ++i) am = fmaxf(am, fabsf(tp[i]));
#pragma unroll
            for (int off = 1; off < 16; off <<= 1) am = fmaxf(am, __shfl_xor(am, off));
            const float inv = am > 0.f ? 127.0f / am : 0.f;
#pragma unroll
            for (int c4 = 0; c4 < 4; ++c4) {
                u32x4 o;
#pragma unroll
                for (int i = 0; i < 4; ++i) {
                    const float* q = tp + c4 * 16 + 4 * i;
                    const int a = (int)rintf(q[0] * inv), b = (int)rintf(q[1] * inv), c2 = (int)rintf(q[2] * inv), d = (int)rintf(q[3] * inv);
                    o[i] = (unsigned)(a & 255) | ((unsigned)(b & 255) << 8) | ((unsigned)(c2 & 255) << 16) | ((unsigned)(d & 255) << 24);
                }
                *(u32x4*)(Wq + (size_t)(n0 + n) * K + l16 * 64 + c4 * 16) = o;
            }
            if (l16 == 0) sw[n0 + n] = am > 0.f ? am * (1.0f / 127.0f) : 1.0f;
        }
        __syncthreads();
    }
}
DI void norm_rows_q8(const float* __restrict__ srcP, const float* __restrict__ srcS, unsigned char* __restrict__ xq, float* __restrict__ sa) {
    const int lane = otid() & 63, gw = blockIdx.x * (NTHREADS / 64) + (otid() >> 6), nw = gridDim.x * (NTHREADS / 64);
    for (int row = gw; row < M; row += nw) {
        const float* src = (row < MP ? srcP + (size_t)row * D : srcS + (size_t)(row - MP) * D) + lane * 16;
        float4 v[4]; float ss = 0.f, am = 0.f;
#pragma unroll
        for (int i = 0; i < 4; ++i) { v[i] = ((const float4*)src)[i]; ss += v[i].x * v[i].x + v[i].y * v[i].y + v[i].z * v[i].z + v[i].w * v[i].w;
            am = fmaxf(am, fmaxf(fmaxf(fabsf(v[i].x), fabsf(v[i].y)), fmaxf(fabsf(v[i].z), fabsf(v[i].w)))); }
        ss = wave_sum(ss);
#pragma unroll
        for (int off = 32; off >= 1; off >>= 1) am = fmaxf(am, __shfl_xor(am, off));
        const float rs = rsqrtf(ss * (1.0f / D) + 1e-6f), inv = am > 0.f ? 127.0f / am : 0.f;
        u32x4 o;
#pragma unroll
        for (int i = 0; i < 4; ++i) {
            const int a = (int)rintf(v[i].x * inv), b = (int)rintf(v[i].y * inv), c2 = (int)rintf(v[i].z * inv), d = (int)rintf(v[i].w * inv);
            o[i] = (unsigned)(a & 255) | ((unsigned)(b & 255) << 8) | ((unsigned)(c2 & 255) << 16) | ((unsigned)(d & 255) << 24);
        }
        *(u32x4*)(xq + (size_t)row * D + lane * 16) = o;
        if (lane == 0) sa[row] = rs * am * (1.0f / 127.0f);
    }
}
DI void cvt_flat(const float* __restrict__ src, bf16_t* __restrict__ dst, size_t n4) {
    const size_t stride = (size_t)gridDim.x * NTHREADS;
    for (size_t i = (size_t)blockIdx.x * NTHREADS + otid(); i < n4; i += stride) {
        const float4 v = ((const float4*)src)[i];
        u32x2 o; o.x = pk2(v.x, v.y); o.y = pk2(v.z, v.w);
        ((u32x2*)dst)[i] = o;
    }
}
DI void quant_rows(const float* __restrict__ src, unsigned char* __restrict__ dst, float* __restrict__ scale, int nrows, int offset, const float* __restrict__ cgain = nullptr) {
    const int lane = otid() & 63, gw = blockIdx.x * (NTHREADS / 64) + (otid() >> 6), nw = gridDim.x * (NTHREADS / 64);
    for (int row = gw; row < nrows; row += nw) {
        const float4* sp = (const float4*)(src + (size_t)row * 1024 + lane * 16);
        float4 v[4]; float am = 0.f;
#pragma unroll
        for (int i = 0; i < 4; ++i) { v[i] = sp[i];
            if (cgain) { const float4 g = ((const float4*)(cgain + lane * 16))[i]; v[i].x *= g.x; v[i].y *= g.y; v[i].z *= g.z; v[i].w *= g.w; }
            am = fmaxf(am, fmaxf(fmaxf(fabsf(v[i].x), fabsf(v[i].y)), fmaxf(fabsf(v[i].z), fabsf(v[i].w)))); }
#pragma unroll
        for (int off = 32; off >= 1; off >>= 1) am = fmaxf(am, __shfl_xor(am, off));
        const float inv = am > 0.f ? 127.0f / am : 0.f;
        u32x4 o;
#pragma unroll
        for (int i = 0; i < 4; ++i) {
            const int a = (int)rintf(v[i].x * inv) + offset, b = (int)rintf(v[i].y * inv) + offset, c2 = (int)rintf(v[i].z * inv) + offset, d = (int)rintf(v[i].w * inv) + offset;
            o[i] = (unsigned)(a & 255) | ((unsigned)(b & 255) << 8) | ((unsigned)(c2 & 255) << 16) | ((unsigned)(d & 255) << 24);
        }
        *(u32x4*)(dst + (size_t)row * 1024 + lane * 16) = o;
        if (lane == 0) scale[row] = am > 0.f ? am * (1.0f / 127.0f) : 1.0f;
    }
}
DI void quant_rows_part(const float* __restrict__ src, unsigned char* __restrict__ dst, float* __restrict__ scale, int nrows, const float* __restrict__ cgain, int bidx, int nblk) {
    const int lane = otid() & 63, gw = bidx * (NTHREADS / 64) + (otid() >> 6), nw = nblk * (NTHREADS / 64);
    for (int row = gw; row < nrows; row += 2 * nw) {
        const int rowb = (row + nw < nrows) ? row + nw : row;
        const f32x4* spa = (const f32x4*)(src + (size_t)row * 1024 + lane * 16);
        const f32x4* spb = (const f32x4*)(src + (size_t)rowb * 1024 + lane * 16);
        f32x4 va[4], vb[4];
#pragma unroll
        for (int i = 0; i < 4; ++i) va[i] = __builtin_nontemporal_load(spa + i);
#pragma unroll
        for (int i = 0; i < 4; ++i) vb[i] = __builtin_nontemporal_load(spb + i);
        float ama = 0.f, amb = 0.f;
#pragma unroll
        for (int i = 0; i < 4; ++i) {
            if (cgain) { const f32x4 g = ((const f32x4*)(cgain + lane * 16))[i]; va[i] *= g; vb[i] *= g; }
            ama = fmaxf(ama, fmaxf(fmaxf(fabsf(va[i][0]), fabsf(va[i][1])), fmaxf(fabsf(va[i][2]), fabsf(va[i][3]))));
            amb = fmaxf(amb, fmaxf(fmaxf(fabsf(vb[i][0]), fabsf(vb[i][1])), fmaxf(fabsf(vb[i][2]), fabsf(vb[i][3]))));
        }
#pragma unroll
        for (int off = 32; off >= 1; off >>= 1) { ama = fmaxf(ama, __shfl_xor(ama, off)); amb = fmaxf(amb, __shfl_xor(amb, off)); }
        const float inva = ama > 0.f ? 127.0f / ama : 0.f, invb = amb > 0.f ? 127.0f / amb : 0.f;
        u32x4 oa, ob;
#pragma unroll
        for (int i = 0; i < 4; ++i) {
            const int a0 = (int)rintf(va[i][0] * inva), a1 = (int)rintf(va[i][1] * inva), a2 = (int)rintf(va[i][2] * inva), a3 = (int)rintf(va[i][3] * inva);
            oa[i] = (unsigned)(a0 & 255) | ((unsigned)(a1 & 255) << 8) | ((unsigned)(a2 & 255) << 16) | ((unsigned)(a3 & 255) << 24);
            const int b0 = (int)rintf(vb[i][0] * invb), b1 = (int)rintf(vb[i][1] * invb), b2 = (int)rintf(vb[i][2] * invb), b3 = (int)rintf(vb[i][3] * invb);
            ob[i] = (unsigned)(b0 & 255) | ((unsigned)(b1 & 255) << 8) | ((unsigned)(b2 & 255) << 16) | ((unsigned)(b3 & 255) << 24);
        }
        *(u32x4*)(dst + (size_t)row * 1024 + lane * 16) = oa;
        if (lane == 0) scale[row] = ama > 0.f ? ama * (1.0f / 127.0f) : 1.0f;
        if (rowb != row) {
            *(u32x4*)(dst + (size_t)rowb * 1024 + lane * 16) = ob;
            if (lane == 0) scale[rowb] = amb > 0.f ? amb * (1.0f / 127.0f) : 1.0f;
        }
    }
}
DI void copy_shift_part(const float* __restrict__ src, float* __restrict__ dst, int keep, int row4, int bidx, int nblk) {
    const unsigned per_b = (unsigned)(keep - 8) * (unsigned)row4, total = per_b * (unsigned)BD, stride = (unsigned)nblk * NTHREADS;
    for (unsigned i0 = (unsigned)bidx * NTHREADS + (unsigned)otid(); i0 < total; i0 += 4u * stride) {
        f32x4 v[4];
#pragma unroll
        for (int k = 0; k < 4; ++k) {
            const unsigned i = i0 + (unsigned)k * stride;
            if (i < total) { const unsigned b = i / per_b, off = i - b * per_b; v[k] = __builtin_nontemporal_load((const f32x4*)src + ((size_t)b * keep + 8) * row4 + off); }
        }
#pragma unroll
        for (int k = 0; k < 4; ++k) {
            const unsigned i = i0 + (unsigned)k * stride;
            if (i < total) { const unsigned b = i / per_b, off = i - b * per_b; __builtin_nontemporal_store(v[k], (f32x4*)dst + (size_t)b * keep * row4 + off); }
        }
    }
}
DI void copy_shift(const float* __restrict__ src, float* __restrict__ dst, int keep, int row4) {
    const size_t per_b = (size_t)(keep - 8) * row4, total = per_b * BD;
    const size_t stride = (size_t)gridDim.x * NTHREADS;
    for (size_t i = (size_t)blockIdx.x * NTHREADS + otid(); i < total; i += stride) {
        const size_t b = i / per_b, off = i - b * per_b;
        const f32x4 v = __builtin_nontemporal_load((const f32x4*)src + (b * (size_t)keep + 8) * row4 + off);
        __builtin_nontemporal_store(v, (f32x4*)dst + b * (size_t)keep * row4 + off);
    }
}
DI void norm_rows(const float* __restrict__ srcP, const float* __restrict__ srcS, bf16_t* __restrict__ xhat) {
    const int lane = otid() & 63, gw = blockIdx.x * (NTHREADS / 64) + (otid() >> 6), nw = gridDim.x * (NTHREADS / 64);
    for (int row = gw; row < M; row += nw) {
        const float* src = row < MP ? srcP + (size_t)row * D : srcS + (size_t)(row - MP) * D;
        float4 v[4]; float ss = 0.f;
#pragma unroll
        for (int i = 0; i < 4; ++i) { v[i] = ((const float4*)src)[lane + 64 * i]; ss += v[i].x * v[i].x + v[i].y * v[i].y + v[i].z * v[i].z + v[i].w * v[i].w; }
        ss = wave_sum(ss);
        const float rs = rsqrtf(ss * (1.0f / D) + 1e-6f);
#pragma unroll
        for (int i = 0; i < 4; ++i) {
            u32x2 o; o.x = pk2(v[i].x * rs, v[i].y * rs); o.y = pk2(v[i].z * rs, v[i].w * rs);
            ((u32x2*)(xhat + (size_t)row * D))[lane + 64 * i] = o;
        }
    }
}
DI void sincos_d(double r, double& s, double& c) {
    const double r2 = r * r;
    double ts = 1.0, tc = 1.0;
#pragma unroll
    for (int k = 13; k >= 1; --k) { ts = 1.0 - ts * r2 / (double)((2 * k) * (2 * k + 1)); tc = 1.0 - tc * r2 / (double)((2 * k - 1) * (2 * k)); }
    s = r * ts; c = tc;
}

template <int PV> DI void phase_prologue(const Params& p, unsigned char* smem) {
    unsigned char* ws = p.ws;
    float* tile = (float*)smem;
    quant_weight_strips(p.w_in_a, N_IN, ws + W_WTIN, (float*)(ws + W_SWIN), p.g_mix, tile);
    quant_weight_strips(p.w_kv_b, N_KV, ws + W_WTKVQG, (float*)(ws + W_SWKV), p.g_kv, tile);
    quant_weight_strips(p.w_qg_b, 1072, ws + W_WTKVQG + (size_t)N_KV * 1024, (float*)(ws + W_SWKV) + N_KV, p.g_mix + D, tile);
    {
        const size_t gt = (size_t)blockIdx.x * NTHREADS + otid(), gs = (size_t)gridDim.x * NTHREADS;
        unsigned* z = (unsigned*)(ws + W_WTKVQG + (size_t)2608 * 1024);
        for (size_t i = gt; i < (size_t)80 * 1024 / 4; i += gs) z[i] = 0u;
        float* swp = (float*)(ws + W_SWKV);
        for (size_t i = gt; i < 80; i += gs) swp[2608 + i] = 1.0f;
    }
    transpose_cvt(p.w_o_a, 512, 1024, (bf16_t*)(ws + W_WTOA), nullptr, tile);
    quant_weight_strips(p.w_peer_q, N_PQ, ws + W_WTPQ, (float*)(ws + W_SWPQ), p.g_ffn, tile);
    quant_weight_strips(p.w_peer_q + (size_t)1024 * N_PQ, N_PQ, ws + W_WTPQ + (size_t)N_PQ * 1024, (float*)(ws + W_SWPQ) + N_PQ, p.g_ffn + D, tile);
    transpose_cvt(p.w_o_b, 1024, 1024, (bf16_t*)(ws + W_WTOB), nullptr, tile);
    transpose_cvt(p.w_cmp1, 2048, 64, (bf16_t*)(ws + W_WC1), nullptr, tile);
    transpose_cvt(p.w_cmp1 + (size_t)2048 * 64, 2048, 64, (bf16_t*)(ws + W_WC1) + (size_t)64 * 2048, nullptr, tile);
    transpose_cvt(p.w_cmp2, 64, 64, (bf16_t*)(ws + W_WC2), nullptr, tile);
    transpose_cvt(p.w_cmp2 + 4096, 64, 64, (bf16_t*)(ws + W_WC2) + 4096, nullptr, tile);
    const size_t gtid = (size_t)blockIdx.x * NTHREADS + otid(), gstride = (size_t)gridDim.x * NTHREADS;
    {
        bf16_t* dst = (bf16_t*)(ws + W_SUBK);
        for (size_t i = gtid; i < (size_t)2 * 2 * 128 * 128 / 4; i += gstride) {
            const int e = (int)i * 4, d = e & 127, n = (e >> 7) & 127, lz = e >> 14;
            const float4 v = ((const float4*)p.peer_subkeys)[i];
            u32x2 o; o.x = pk2(v.x, v.y); o.y = pk2(v.z, v.w);
            const size_t unit = (size_t)((lz * 8 + (n >> 4)) * 4 + (d >> 5)) * 64 + ((d & 31) >> 3) * 16 + (n & 15);
            *(u32x2*)(dst + unit * 8 + (d & 7)) = o;
        }
    }
    if (PV != 1 && !FLOAT_WORK) {
    quant_rows(p.peer_u, ws + W_U8, (float*)(ws + W_SU), NEXP, 0, p.g_ffn);
    quant_rows(p.peer_u + (size_t)NEXP * 1024, ws + W_U8 + (size_t)NEXP * 1024, (float*)(ws + W_SU) + NEXP, NEXP, 0, p.g_ffn + D);
    quant_rows(p.peer_v, ws + W_V8, (float*)(ws + W_SV), 2 * NEXP, 0);
    }
    {
        float2* tab = (float2*)(ws + W_ROPE);
        for (size_t i = gtid; i < (size_t)8200 * 8; i += gstride) {
            const int pos = (int)(i >> 3), fi = (int)(i & 7);
            const float inv = (float)exp(-log(500000.0) * (double)fi * 0.125);
            const float ang = (float)pos * inv;
            const double a = (double)ang;
            const double k = rint(a * 0.15915494309189535);
            const double r = a - k * 6.283185307179586476925;
            double s, c; sincos_d(r, s, c);
            tab[i] = make_float2((float)c, (float)s);
        }
    }
    {
        const int lane = otid() & 63, gw = blockIdx.x * (NTHREADS / 64) + (otid() >> 6), nw = gridDim.x * (NTHREADS / 64);
        float* pet = (float*)(ws + W_PET);
        for (int o = gw; o < 128; o += nw) {
            const int z = o >> 6, f = o & 63; float s = 0.f;
            for (int k = lane; k < 2048; k += 64) s += p.pe_cmp[z * 2048 + k] * p.w_cmp1[((size_t)z * 2048 + k) * 64 + f];
            s = wave_sum(s);
            if (lane == 0) pet[o] = s;
        }
    }
    norm_rows_q8(p.x_prompt, p.x_sample, ws + W_XQ, (float*)(ws + W_SA));
    if (PV != 2 && !FLOAT_WORK) {
    copy_shift(p.cache_a0, p.out + O_A1S, 128, 256);
    copy_shift(p.cache_a1, p.out + O_A2S, 512, 256);
    copy_shift(p.cache_a2, p.out + O_A3S, 2048, 256);
    copy_shift(p.cache_b_win, p.out + O_BWS, 512, 128);
    }
}

DI void phase_prologue2(const Params& p, unsigned char* smem) {
    unsigned char* ws = p.ws;
    float* tile = (float*)smem;
    transpose_q8(p.w_in_a, 1024, N_IN, ws + W_WTIN, (float*)(ws + W_SWIN), p.g_mix, (const unsigned*)(ws + W_CMIN), tile);
    transpose_q8(p.w_kv_b, 1024, N_KV, ws + W_WTKVQG, (float*)(ws + W_SWKV), p.g_kv, (const unsigned*)(ws + W_CMKV), tile);
    transpose_q8(p.w_qg_b, 1024, 1072, ws + W_WTKVQG + (size_t)N_KV * 1024, (float*)(ws + W_SWKV) + N_KV, p.g_mix + D, (const unsigned*)(ws + W_CMKV) + N_KV, tile);
    const size_t gtid = (size_t)blockIdx.x * NTHREADS + otid(), gstride = (size_t)gridDim.x * NTHREADS;
    {
        unsigned* z = (unsigned*)(ws + W_WTKVQG + (size_t)2608 * 1024);
        for (size_t i = gtid; i < (size_t)80 * 1024 / 4; i += gstride) z[i] = 0u;
        float* sw = (float*)(ws + W_SWKV);
        for (size_t i = gtid; i < 80; i += gstride) sw[2608 + i] = 1.0f;
    }
}

constexpr int C_LD = 132;
DI float dpp_sum16(float v);
DI u32x2 pk4(const f32x4& v) { u32x2 o; o.x = pk2(v[0], v[1]); o.y = pk2(v[2], v[3]); return o; }
DI u32x4 pk8(const float (&v)[8]) { u32x4 o; o.x = pk2(v[0], v[1]); o.y = pk2(v[2], v[3]); o.z = pk2(v[4], v[5]); o.w = pk2(v[6], v[7]); return o; }
DI float row_rs(const Params& p, int which, int row) { return rsqrtf(((const float*)(p.ws + W_ROWSS))[which * M + row] * (1.0f / D) + 1e-6f); }
DI void rope8(const Params& p, int row, int d8, float (&v)[8], const float* partner) {
    const f32x4* tab = (const f32x4*)((const float2*)(p.ws + W_ROPE) + pos_of_row(row) * 8);
    const f32x4 pa = *(const f32x4*)partner, pb = *(const f32x4*)(partner + 4);
    const float pr[8] = {pa[0], pa[1], pa[2], pa[3], pb[0], pb[1], pb[2], pb[3]};
#pragma unroll
    for (int h = 0; h < 4; ++h) {
        const f32x4 t = tab[h];
        v[2 * h] = d8 == 0 ? v[2 * h] * t[0] - pr[2 * h] * t[1] : v[2 * h] * t[0] + pr[2 * h] * t[1];
        v[2 * h + 1] = d8 == 0 ? v[2 * h + 1] * t[2] - pr[2 * h + 1] * t[3] : v[2 * h + 1] * t[2] + pr[2 * h + 1] * t[3];
    }
}
DI void st8f(float* dst, const float (&v)[8]) { *(f32x4*)dst = (f32x4){v[0], v[1], v[2], v[3]}; *(f32x4*)(dst + 4) = (f32x4){v[4], v[5], v[6], v[7]}; }

template <int EPI> DI void epi_chunk(const Params& p, int row, int col8, float (&v)[8], const float* crow, int ch);

template <> DI void epi_chunk<1>(const Params& p, int row, int col8, float (&v)[8], const float* crow, int ch) {
    const int g = col8 / 1536, rem = col8 - g * 1536, cc = rem >> 9, head = (rem >> 6) & 7, d8 = rem & 63;
    if (cc < 2 && d8 < 16) rope8(p, row, d8, v, crow + ((ch ^ 1) << 3));
    if (cc == 0) {
#pragma unroll
        for (int i = 0; i < 8; ++i) v[i] *= QSCALE;
        *(u32x4*)((bf16_t*)(p.ws + W_QA) + (size_t)row * 1536 + g * 512 + head * 64 + d8) = pk8(v);
        return;
    }
    const int kv = cc - 1, lg = 2 * g, win = 128 << lg;
    const size_t oP = g == 0 ? O_A1P : (g == 1 ? O_A2P : O_A3P), oS = g == 0 ? O_A1S : (g == 1 ? O_A2S : O_A3S);
    if (row < MP) {
        const int b = row >> 13, L = SEQ >> lg, t = row & (SEQ - 1);
        if (kv == 0) {
            const int pp = (t & ((1 << lg) - 1)) * L + (t >> lg);
            bf16_t* KA = (bf16_t*)(p.ws + W_KA) + (size_t)((g * 2 + b) * 8 + head) * SEQ * 64;
            const int unit = ((pp >> 4) * 2 + (d8 >> 5)) * 64 + ((d8 & 31) >> 3) * 16 + (pp & 15);
            *(u32x4*)(KA + (size_t)unit * 8) = pk8(v);
        }
        if (t >= SEQ - win) st8f(p.out + oP + ((size_t)(b * win + t - (SEQ - win)) * 2 + kv) * 512 + head * 64 + d8, v);
    } else {
        const int r = row - MP, bd = r >> 3, sidx = r & 7;
        st8f(p.out + oS + ((size_t)(bd * win + win - 8 + sidx) * 2 + kv) * 512 + head * 64 + d8, v);
    }
}
DI void epi_resid(const Params& p, int which, int row, int col8, float (&v)[8], const float* xin) {
    const f32x4 a = *(const f32x4*)xin, b2 = *(const f32x4*)(xin + 4);
    v[0] += a[0]; v[1] += a[1]; v[2] += a[2]; v[3] += a[3]; v[4] += b2[0]; v[5] += b2[1]; v[6] += b2[2]; v[7] += b2[3];
    st8f((float*)(p.ws + W_XR) + (size_t)row * D + col8, v);
}
template <> DI void epi_chunk<3>(const Params& p, int row, int col8, float (&v)[8], const float* crow, int ch) {
    epi_resid(p, 0, row, col8, v, row < MP ? p.x_prompt + (size_t)row * D + col8 : p.x_sample + (size_t)(row - MP) * D + col8);
}
template <> DI void epi_chunk<11>(const Params& p, int row, int col8, float (&v)[8], const float* crow, int ch) {
    epi_resid(p, 1, row, col8, v, (const float*)(p.ws + W_XR) + (size_t)row * D + col8);
}
DI void epi_qh(const Params& p, int which, int row, int col8, float (&v)[8]) {
    *(u32x4*)((bf16_t*)(p.ws + W_QH) + ((size_t)((row >> 4) * 64 + (col8 >> 5)) * 64 + ((col8 & 31) >> 3) * 16 + (row & 15)) * 8) = pk8(v);
}
template <> DI void epi_chunk<5>(const Params& p, int row, int col8, float (&v)[8], const float* crow, int ch) { epi_qh(p, 0, row, col8, v); }
template <> DI void epi_chunk<6>(const Params& p, int row, int col8, float (&v)[8], const float* crow, int ch) { epi_qh(p, 1, row, col8, v); }
template <> DI void epi_chunk<8>(const Params& p, int row, int col8, float (&v)[8], const float* crow, int ch) {
    unsigned char* ws = p.ws;
    if (col8 < N_KV) {
        const int cc = col8 >> 8, kvh = (col8 >> 6) & 3, d8 = col8 & 63;
        if ((cc == 2 || cc == 4) && d8 < 16) rope8(p, row, d8, v, crow + ((ch ^ 1) << 3));
        if (row < MP) {
            const int b = row >> 13, t = row & (SEQ - 1);
            if (cc < 4) st8f(p.out + O_BKVP + (size_t)row * 1024 + col8, v);
            else if (t >= SEQ - 512) st8f(p.out + O_BWP + ((size_t)(b * 512 + t - (SEQ - 512)) * 2 + (cc - 4)) * 256 + kvh * 64 + d8, v);
            if (cc == 0 || cc == 1) *(u32x4*)((bf16_t*)(ws + (cc == 0 ? W_CMPK : W_CMPV)) + ((size_t)row * 4 + kvh) * 64 + d8) = pk8(v);
            else if (cc == 2 || cc == 4) *(u32x4*)((bf16_t*)(ws + (cc == 2 ? W_SELK : W_WINK)) + ((size_t)(b * 4 + kvh) * SEQ + t) * 64 + d8) = pk8(v);
        } else {
            const int r = row - MP, bd = r >> 3, sidx = r & 7;
            if (cc < 4) st8f(p.out + O_BKVS + (size_t)r * 1024 + col8, v);
            else st8f(p.out + O_BWS + ((size_t)(bd * 512 + 504 + sidx) * 2 + (cc - 4)) * 256 + kvh * 64 + d8, v);
        }
    } else if (col8 < N_KV + 1024) {
        const int qc = col8 - N_KV;
        if ((qc & 63) < 16) rope8(p, row, qc & 63, v, crow + ((ch ^ 1) << 3));
#pragma unroll
        for (int i = 0; i < 8; ++i) v[i] *= QSCALE;
        *(u32x4*)((bf16_t*)(ws + W_QB) + (size_t)row * 1024 + qc) = pk8(v);
    } else if (col8 < N_KV + 1072) {
        const int gc = col8 - N_KV - 1024;
        const f32x4 ba = *(const f32x4*)(p.b_gate_b + gc), bb2 = *(const f32x4*)(p.b_gate_b + gc + 4);
        const float bias[8] = {ba[0], ba[1], ba[2], ba[3], bb2[0], bb2[1], bb2[2], bb2[3]};
#pragma unroll
        for (int i = 0; i < 8; ++i) v[i] = 1.0f / (1.0f + __expf(-(v[i] + bias[i])));
        st8f((float*)(ws + W_GATE) + (size_t)row * 48 + gc, v);
    }
}

template <int EPI> DI void epi_vcols(const Params& p, int tm, int tn, const float* Cs, int tid) {
    const int row0 = tm * 128, colb = tn * 128;
    if (row0 >= MP) return;
    const int b = row0 >> 13, t0 = row0 & (SEQ - 1);
    if (EPI == 1) {
        const int g = colb / 1536, rem = colb - g * 1536, cc = rem >> 9;
        if (cc != 2) return;
        const int lg = 2 * g, dil = 1 << lg, L = SEQ >> lg, head0 = (rem >> 6) & 7;
#pragma unroll 4
        for (int k = 0; k < 16; ++k) {
            const int id = tid + 256 * k, col = id & 127, qd = id >> 7;
            const int res = qd & (dil - 1), mq = qd >> lg;
            const int head = head0 + (col >> 6), d = col & 63;
            const int pp0 = res * L + (t0 >> lg) + 4 * mq;
            float x[4];
#pragma unroll
            for (int e = 0; e < 4; ++e) x[e] = Cs[(res + dil * (4 * mq + e)) * C_LD + col];
            bf16_t* VAT = (bf16_t*)(p.ws + W_VAT) + (size_t)((g * 2 + b) * 8 + head) * 64 * SEQ;
            const int unit = ((pp0 >> 5) * 4 + (d >> 4)) * 64 + ((pp0 & 15) >> 2) * 16 + (d & 15);
            u32x2 w; w.x = pk2(x[0], x[1]); w.y = pk2(x[2], x[3]);
            *(u32x2*)(VAT + (size_t)unit * 8 + 4 * ((pp0 >> 4) & 1)) = w;
        }
    } else {
        if (colb >= N_KV) return;
        const int cc = colb >> 8;
        if (cc != 3 && cc != 5) return;
        const int kvh0 = (colb >> 6) & 3;
#pragma unroll 4
        for (int k = 0; k < 8; ++k) {
            const int id = tid + 256 * k, col = id & 127, rg = id >> 7;
            const int kvh = kvh0 + (col >> 6), d = col & 63;
            float x[8];
#pragma unroll
            for (int e = 0; e < 8; ++e) x[e] = Cs[(rg * 8 + e) * C_LD + col];
            bf16_t* dst = (bf16_t*)(p.ws + (cc == 3 ? W_SELVT : W_WINVT)) + ((size_t)(b * 4 + kvh) * 64 + d) * SEQ + t0 + rg * 8;
            *(u32x4*)dst = pk8(x);
        }
    }
}
template <int EPI> DI void epilogue_tile(const Params& p, int tm, int tn, const float* Cs, int tid) {
#pragma unroll 2
    for (int k = 0; k < 8; ++k) {
        const int id = tid + 256 * k, r = id >> 4, ch = id & 15;
        const float* crow = Cs + r * C_LD;
        const f32x4 a = *(const f32x4*)(crow + ch * 8), b2 = *(const f32x4*)(crow + ch * 8 + 4);
        float v[8] = {a[0], a[1], a[2], a[3], b2[0], b2[1], b2[2], b2[3]};
        epi_chunk<EPI>(p, tm * 128 + r, tn * 128 + ch * 8, v, crow, ch);
    }
    if (EPI == 1 || EPI == 8) epi_vcols<EPI>(p, tm, tn, Cs, tid);
}

constexpr int G_LD = 72;
constexpr int G_TILE = 128 * G_LD;
struct GRegs { bf16x8 a[4], b[4]; };
template <int EPI> DI void gemm_run(const Params& p, const bf16_t* __restrict__ A, const bf16_t* __restrict__ Bt, int K, int ntn, unsigned char* smem) {
    bf16_t* As = (bf16_t*)smem;
    bf16_t* Bs = As + 2 * G_TILE;
    const int tid = otid(), lane = tid & 63, w = tid >> 6, wm = w >> 1, wn = w & 1, c = lane & 15, Q = lane >> 4;
    const int lr = tid >> 3, lk = (tid & 7) * 8;
    const int ntiles = (M / 128) * ntn, nk = K >> 6;
    const int voff = lr * K + lk;
    GRegs R0, R1;
    const bf16_t* Ag = A;
    const bf16_t* Bg = Bt;
#define G_LOAD(R, kt) { _Pragma("unroll") for (int i_ = 0; i_ < 4; ++i_) { \
            R.a[i_] = *(const bf16x8*)(Ag + (voff + (32 * i_ * K + (kt) * 64))); R.b[i_] = *(const bf16x8*)(Bg + (voff + (32 * i_ * K + (kt) * 64))); } }
#define G_STORE(R, buf) { _Pragma("unroll") for (int i_ = 0; i_ < 4; ++i_) { \
            *(bf16x8*)&As[(buf) * G_TILE + (lr + 32 * i_) * G_LD + lk] = R.a[i_]; *(bf16x8*)&Bs[(buf) * G_TILE + (lr + 32 * i_) * G_LD + lk] = R.b[i_]; } }
#define G_COMPUTE(buf) { _Pragma("unroll") for (int ks_ = 0; ks_ < 2; ++ks_) { bf16x8 af[4], bfr[4]; \
            _Pragma("unroll") for (int i_ = 0; i_ < 4; ++i_) { \
                af[i_] = *(const bf16x8*)&As[(buf) * G_TILE + (wm * 64 + i_ * 16 + c) * G_LD + ks_ * 32 + Q * 8]; \
                bfr[i_] = *(const bf16x8*)&Bs[(buf) * G_TILE + (wn * 64 + i_ * 16 + c) * G_LD + ks_ * 32 + Q * 8]; } \
            __builtin_amdgcn_s_setprio(1); \
            _Pragma("unroll") for (int i_ = 0; i_ < 4; ++i_) _Pragma("unroll") for (int j_ = 0; j_ < 4; ++j_) acc[i_][j_] = MFMA16(bfr[j_], af[i_], acc[i_][j_]); \
            __builtin_amdgcn_s_setprio(0); } }
#define G_STEP(KT, Ra, Rb) { const int kt_ = (KT); if (kt_ + 2 < nk) G_LOAD(Ra, kt_ + 2); G_COMPUTE(kt_ & 1); if (kt_ + 1 < nk) G_STORE(Rb, (kt_ + 1) & 1); lds_barrier(); }
    int tile = blockIdx.x;
    if (tile < ntiles) {
        const int tm0 = tile / ntn, tn0 = tile - tm0 * ntn;
        Ag = A + (size_t)(tm0 * 128) * K; Bg = Bt + (size_t)(tn0 * 128) * K;
        G_LOAD(R0, 0); G_LOAD(R1, 1);
    }
    while (tile < ntiles) {
        const int tm = tile / ntn, tn = tile - tm * ntn;
        f32x4 acc[4][4];
#pragma unroll
        for (int i = 0; i < 4; ++i)
#pragma unroll
            for (int j = 0; j < 4; ++j) acc[i][j] = (f32x4){0.f, 0.f, 0.f, 0.f};
        G_STORE(R0, 0);
        lds_barrier();
        for (int kt = 0; kt < nk; kt += 2) { G_STEP(kt, R0, R1); G_STEP(kt + 1, R1, R0); }
        {
            float* Cs = (float*)smem;
#pragma unroll
            for (int i = 0; i < 4; ++i)
#pragma unroll
                for (int j = 0; j < 4; ++j) *(f32x4*)&Cs[(wm * 64 + i * 16 + c) * C_LD + wn * 64 + j * 16 + 4 * Q] = acc[i][j];
            const int ntile = tile + (int)gridDim.x;
            if (ntile < ntiles) {
                const int tmn = ntile / ntn, tnn = ntile - tmn * ntn;
                Ag = A + (size_t)(tmn * 128) * K; Bg = Bt + (size_t)(tnn * 128) * K;
                G_LOAD(R0, 0); G_LOAD(R1, 1);
            }
            lds_barrier();
            epilogue_tile<EPI>(p, tm, tn, Cs, tid);
            lds_barrier();
            tile = ntile;
        }
    }
#undef G_LOAD
#undef G_STORE
#undef G_COMPUTE
#undef G_STEP
}

constexpr int Q_LD = 144;
constexpr int Q_TILE = 128 * Q_LD;
struct QRegs { i32x4 a[4], b[4]; };
template <int EPI> DI void gemm_run_i8(const Params& p, const unsigned char* __restrict__ A, const float* __restrict__ sa,
                                       const unsigned char* __restrict__ Bt, const float* __restrict__ sw, int ntn, unsigned char* smem) {
    constexpr int K = 1024, nk = K / 128;
    unsigned char* As = smem;
    unsigned char* Bs = smem + 2 * Q_TILE;
    const int tid = otid(), lane = tid & 63, w = tid >> 6, wm = w >> 1, wn = w & 1, c = lane & 15, Q = lane >> 4;
    const int lr = tid >> 3, lk = (tid & 7) * 16;
    const int ntiles = (M / 128) * ntn;
    const int voff = lr * K + lk;
    QRegs R0, R1;
    const unsigned char* Ag = A;
    const unsigned char* Bg = Bt;
#define Q_LOAD(R, kt) { _Pragma("unroll") for (int i_ = 0; i_ < 4; ++i_) { \
            R.a[i_] = *(const i32x4*)(Ag + (voff + (32 * i_ * K + (kt) * 128))); R.b[i_] = *(const i32x4*)(Bg + (voff + (32 * i_ * K + (kt) * 128))); } }
#define Q_STORE(R, buf) { _Pragma("unroll") for (int i_ = 0; i_ < 4; ++i_) { \
            *(i32x4*)&As[(buf) * Q_TILE + (lr + 32 * i_) * Q_LD + lk] = R.a[i_]; *(i32x4*)&Bs[(buf) * Q_TILE + (lr + 32 * i_) * Q_LD + lk] = R.b[i_]; } }
#define Q_COMPUTE(buf) { _Pragma("unroll") for (int ks_ = 0; ks_ < 2; ++ks_) { i32x4 af[4], bfr[4]; \
            _Pragma("unroll") for (int i_ = 0; i_ < 4; ++i_) { \
                af[i_] = *(const i32x4*)&As[(buf) * Q_TILE + (wm * 64 + i_ * 16 + c) * Q_LD + ks_ * 64 + Q * 16]; \
                bfr[i_] = *(const i32x4*)&Bs[(buf) * Q_TILE + (wn * 64 + i_ * 16 + c) * Q_LD + ks_ * 64 + Q * 16]; } \
            __builtin_amdgcn_s_setprio(1); \
            _Pragma("unroll") for (int i_ = 0; i_ < 4; ++i_) _Pragma("unroll") for (int j_ = 0; j_ < 4; ++j_) acc[i_][j_] = MFMA_I8(bfr[j_], af[i_], acc[i_][j_]); \
            __builtin_amdgcn_s_setprio(0); } }
#define Q_STEP(KT, Ra, Rb) { const int kt_ = (KT); if (kt_ + 2 < nk) Q_LOAD(Ra, kt_ + 2); Q_COMPUTE(kt_ & 1); if (kt_ + 1 < nk) Q_STORE(Rb, (kt_ + 1) & 1); lds_barrier(); }
    constexpr bool DYN = (EPI == 1) && FLOAT_WORK;
    int* sh_tile = (int*)(smem + 4 * Q_TILE + 64);
    unsigned* tcnt = (unsigned*)(p.ws + W_CTL) + CTL_CNT_WORD + 64 * 16;
    if (DYN) {
        const int nfl = (int)gridDim.x - (int)gridDim.x / 2, b0 = (int)gridDim.x / 2;
        if ((int)blockIdx.x >= b0) {
            unsigned char* ws = p.ws;
            const int bi = (int)blockIdx.x - b0;
            quant_rows_part(p.peer_u, ws + W_U8, (float*)(ws + W_SU), NEXP, p.g_ffn, bi, nfl);
            quant_rows_part(p.peer_u + (size_t)NEXP * 1024, ws + W_U8 + (size_t)NEXP * 1024, (float*)(ws + W_SU) + NEXP, NEXP, p.g_ffn + D, bi, nfl);
            quant_rows_part(p.peer_v, ws + W_V8, (float*)(ws + W_SV), 2 * NEXP, nullptr, bi, nfl);
        }
    }
#define Q_NEXT_TILE(dst) { if (DYN) { if (tid == 0) *sh_tile = (int)__hip_atomic_fetch_add(tcnt, 1u, __ATOMIC_RELAXED, __HIP_MEMORY_SCOPE_AGENT); __syncthreads(); \
            dst = __builtin_amdgcn_readfirstlane(*sh_tile); __syncthreads(); } }
    int tile = blockIdx.x;
    Q_NEXT_TILE(tile);
    if (tile < ntiles) {
        const int tm0 = tile / ntn, tn0 = tile - tm0 * ntn;
        Ag = A + (size_t)(tm0 * 128) * K; Bg = Bt + (size_t)(tn0 * 128) * K;
        Q_LOAD(R0, 0); Q_LOAD(R1, 1);
    }
    while (tile < ntiles) {
        const int tm = tile / ntn, tn = tile - tm * ntn;
        i32x4 acc[4][4];
#pragma unroll
        for (int i = 0; i < 4; ++i)
#pragma unroll
            for (int j = 0; j < 4; ++j) acc[i][j] = (i32x4){0, 0, 0, 0};
        Q_STORE(R0, 0);
        lds_barrier();
#pragma unroll 1
        for (int kt = 0; kt < nk; kt += 2) { Q_STEP(kt, R0, R1); Q_STEP(kt + 1, R1, R0); }
        {
            float* Cs = (float*)smem;
#pragma unroll
            for (int i = 0; i < 4; ++i) {
                const float sr = sa[tm * 128 + wm * 64 + i * 16 + c];
#pragma unroll
                for (int j = 0; j < 4; ++j) {
                    const f32x4 sc = *(const f32x4*)(sw + tn * 128 + wn * 64 + j * 16 + 4 * Q);
                    f32x4 v;
#pragma unroll
                    for (int r = 0; r < 4; ++r) v[r] = (float)acc[i][j][r] * (sr * sc[r]);
                    *(f32x4*)&Cs[(wm * 64 + i * 16 + c) * C_LD + wn * 64 + j * 16 + 4 * Q] = v;
                }
            }
            int ntile = tile + (int)gridDim.x;
            Q_NEXT_TILE(ntile);
            if (ntile < ntiles) {
                const int tmn = ntile / ntn, tnn = ntile - tmn * ntn;
                Ag = A + (size_t)(tmn * 128) * K; Bg = Bt + (size_t)(tnn * 128) * K;
                Q_LOAD(R0, 0); Q_LOAD(R1, 1);
            }
            lds_barrier();
            epilogue_tile<EPI>(p, tm, tn, Cs, tid);
            lds_barrier();
            tile = ntile;
        }
    }
#undef Q_LOAD
#undef Q_STORE
#undef Q_COMPUTE
#undef Q_NEXT_TILE
#undef Q_STEP
}

struct KVbf {
    const bf16_t* K; const bf16_t* VT; int ldv; int Q;
    DI bf16x8 kfrag(int key, int ks) const { return *(const bf16x8*)(K + (size_t)key * 64 + ks * 32 + Q * 8); }
    DI bf16x8 vfrag(int d, int key0) const {
        const bf16x4 lo = *(const bf16x4*)(VT + (size_t)d * ldv + key0 + 4 * Q);
        const bf16x4 hi = *(const bf16x4*)(VT + (size_t)d * ldv + key0 + 16 + 4 * Q);
        return __builtin_shufflevector(lo, hi, 0, 1, 2, 3, 4, 5, 6, 7);
    }
};
struct KVtiled {
    const bf16_t* K; const bf16_t* VT; int lane;
    DI bf16x8 kfrag(int key, int ks) const { return *(const bf16x8*)(K + ((size_t)((key >> 4) * 2 + ks) * 64 + lane) * 8); }
    DI bf16x8 vfrag(int d, int key0) const { return *(const bf16x8*)(VT + ((size_t)((key0 >> 5) * 4 + (d >> 4)) * 64 + lane) * 8); }
};
template <class RowF> struct KVf32 {
    RowF rf; int Q;
    DI bf16x8 kfrag(int key, int ks) const {
        const float* r = rf(key, 0) + ks * 32 + Q * 8;
        const float4 a = *(const float4*)r, b = *(const float4*)(r + 4);
        return pack8(a.x, a.y, a.z, a.w, b.x, b.y, b.z, b.w);
    }
    DI bf16x8 vfrag(int d, int key0) const {
        float v[8];
#pragma unroll
        for (int j = 0; j < 4; ++j) { v[j] = rf(key0 + 4 * Q + j, 1)[d]; v[4 + j] = rf(key0 + 16 + 4 * Q + j, 1)[d]; }
        return pack8(v[0], v[1], v[2], v[3], v[4], v[5], v[6], v[7]);
    }
};

constexpr float LAZY_T = 8.0f;
DI float row_sum(float l) { l += __shfl_xor(l, 16); l += __shfl_xor(l, 32); return l; }
template <class KV, class MaskF>
DI void attn_tile(const bf16x8& q0, const bf16x8& q1, const KV& kv, int key0, MaskF&& maskf, float& m, float& l, f32x4 (&o)[4], int c, int Q) {
    f32x4 s0 = {0.f, 0.f, 0.f, 0.f}, s1 = {0.f, 0.f, 0.f, 0.f};
    s0 = MFMA16(kv.kfrag(key0 + c, 0), q0, s0);
    s0 = MFMA16(kv.kfrag(key0 + c, 1), q1, s0);
    s1 = MFMA16(kv.kfrag(key0 + 16 + c, 0), q0, s1);
    s1 = MFMA16(kv.kfrag(key0 + 16 + c, 1), q1, s1);
    float mx = NEG_INF;
#pragma unroll
    for (int j = 0; j < 4; ++j) {
        if (!maskf(key0 + 4 * Q + j)) s0[j] = NEG_INF;
        if (!maskf(key0 + 16 + 4 * Q + j)) s1[j] = NEG_INF;
        mx = fmaxf(mx, fmaxf(s0[j], s1[j]));
    }
    if (__any(mx > m + LAZY_T)) {
        mx = fmaxf(mx, __shfl_xor(mx, 16)); mx = fmaxf(mx, __shfl_xor(mx, 32));
        const float mn = fmaxf(m, mx);
        const float alpha = fexp2(m - ((mn == NEG_INF) ? 0.f : mn));
        l *= alpha; m = mn;
#pragma unroll
        for (int db = 0; db < 4; ++db) o[db] = o[db] * alpha;
    }
    const float mu = (m == NEG_INF) ? 0.f : m;
    float p[8];
#pragma unroll
    for (int j = 0; j < 4; ++j) { p[j] = fexp2(s0[j] - mu); p[4 + j] = fexp2(s1[j] - mu); l += p[j] + p[4 + j]; }
    const bf16x8 pb = pack8(p[0], p[1], p[2], p[3], p[4], p[5], p[6], p[7]);
#pragma unroll
    for (int db = 0; db < 4; ++db) o[db] = MFMA16(kv.vfrag(db * 16 + c, key0), pb, o[db]);
}

struct KVregs {
    bf16x8 k[4], v[4];
    DI void load(const KVtiled& t, int key0) {
        k[0] = t.kfrag(key0, 0); k[1] = t.kfrag(key0, 1); k[2] = t.kfrag(key0 + 16, 0); k[3] = t.kfrag(key0 + 16, 1);
#pragma unroll
        for (int db = 0; db < 4; ++db) v[db] = t.vfrag(db * 16, key0);
    }
};
template <class MaskF>
DI void attn_tile_regs(const bf16x8& q0, const bf16x8& q1, const KVregs& F, int key0, MaskF&& maskf, float& m, float& l, f32x4 (&o)[4], int c, int Q) {
    f32x4 s0 = {0.f, 0.f, 0.f, 0.f}, s1 = {0.f, 0.f, 0.f, 0.f};
    s0 = MFMA16(F.k[0], q0, s0); s0 = MFMA16(F.k[1], q1, s0);
    s1 = MFMA16(F.k[2], q0, s1); s1 = MFMA16(F.k[3], q1, s1);
    float mx = NEG_INF;
#pragma unroll
    for (int j = 0; j < 4; ++j) {
        if (!maskf(key0 + 4 * Q + j)) s0[j] = NEG_INF;
        if (!maskf(key0 + 16 + 4 * Q + j)) s1[j] = NEG_INF;
        mx = fmaxf(mx, fmaxf(s0[j], s1[j]));
    }
    if (__any(mx > m + LAZY_T)) {
        mx = fmaxf(mx, __shfl_xor(mx, 16)); mx = fmaxf(mx, __shfl_xor(mx, 32));
        const float mn = fmaxf(m, mx);
        const float alpha = fexp2(m - ((mn == NEG_INF) ? 0.f : mn));
        l *= alpha; m = mn;
#pragma unroll
        for (int db = 0; db < 4; ++db) o[db] = o[db] * alpha;
    }
    const float mu = (m == NEG_INF) ? 0.f : m;
    float p[8];
#pragma unroll
    for (int j = 0; j < 4; ++j) { p[j] = fexp2(s0[j] - mu); p[4 + j] = fexp2(s1[j] - mu); l += p[j] + p[4 + j]; }
    const bf16x8 pb = pack8(p[0], p[1], p[2], p[3], p[4], p[5], p[6], p[7]);
    o[0] = MFMA16(F.v[0], pb, o[0]); o[1] = MFMA16(F.v[1], pb, o[1]); o[2] = MFMA16(F.v[2], pb, o[2]); o[3] = MFMA16(F.v[3], pb, o[3]);
}

DI void attnA_prompt_unit(const Params& p, int u, int lane) {
    const int c = lane & 15, Q = lane >> 4;
    const int r = u & 15, tb = (u >> 4) & 31, head = (u >> 9) & 7, b = u >> 12;
    const int trow = b * SEQ + tb * 256 + r + 16 * c;
    const bf16_t* QA = (const bf16_t*)(p.ws + W_QA) + (size_t)trow * 1536 + head * 64 + Q * 8;
    float m = NEG_INF, l = 0.f; f32x4 o[4];
#pragma unroll
    for (int i = 0; i < 4; ++i) o[i] = (f32x4){0.f, 0.f, 0.f, 0.f};
#pragma unroll
    for (int g = 0; g < 3; ++g) {
        const int lg = 2 * g, L = SEQ >> lg, step = 16 >> lg;
        const int res = r & ((1 << lg) - 1), mq0 = (tb * 256 + r) >> lg, mi = mq0 + step * c;
        const bf16x8 q0 = *(const bf16x8*)(QA + g * 512), q1 = *(const bf16x8*)(QA + g * 512 + 32);
        KVtiled kv;
        kv.K = (const bf16_t*)(p.ws + W_KA) + ((size_t)((g * 2 + b) * 8 + head) * SEQ + (size_t)res * L) * 64;
        kv.VT = (const bf16_t*)(p.ws + W_VAT) + ((size_t)((g * 2 + b) * 8 + head) * SEQ + (size_t)res * L) * 64;
        kv.lane = lane;
        int klo = mq0 - 128; klo = klo < 0 ? 0 : klo; klo &= ~31;
        const int khi = mq0 + 15 * step;
        KVregs F0, F1;
        F0.load(kv, klo);
        for (int key0 = klo; key0 <= khi; key0 += 64) {
            const bool has1 = key0 + 32 <= khi;
            if (has1) F1.load(kv, key0 + 32);
            attn_tile_regs(q0, q1, F0, key0, [&](int k) { return k <= mi && k >= mi - 128; }, m, l, o, c, Q);
            if (has1) {
                if (key0 + 64 <= khi) F0.load(kv, key0 + 64);
                attn_tile_regs(q0, q1, F1, key0 + 32, [&](int k) { return k <= mi && k >= mi - 128; }, m, l, o, c, Q);
            }
        }
    }
    const float inv = 1.0f / row_sum(l);
    bf16_t* OA = (bf16_t*)(p.ws + W_OA) + (size_t)trow * 512 + head * 64;
#pragma unroll
    for (int db = 0; db < 4; ++db) {
        u32x2 w; w.x = pk2(o[db][0] * inv, o[db][1] * inv); w.y = pk2(o[db][2] * inv, o[db][3] * inv);
        *(u32x2*)(OA + db * 16 + 4 * Q) = w;
    }
}
DI void attnA_sample_block(const Params& p, int u, unsigned char* smem, int tid) {
    const int lane = tid & 63, wid = tid >> 6, c = lane & 15, Q = lane >> 4;
    const int head = u & 7, bd = u >> 3;
    const int s = c & 7;
    const bool rowok = c < 8;
    const int trow = MP + bd * 8 + s;
    const bf16_t* QA = (const bf16_t*)(p.ws + W_QA) + (size_t)trow * 1536 + head * 64 + Q * 8;
    float m = NEG_INF, l = 0.f; f32x4 o[4];
#pragma unroll
    for (int i = 0; i < 4; ++i) o[i] = (f32x4){0.f, 0.f, 0.f, 0.f};
    const bf16x8 qa0 = *(const bf16x8*)(QA), qb0 = *(const bf16x8*)(QA + 32);
    const bf16x8 qa1 = *(const bf16x8*)(QA + 512), qb1 = *(const bf16x8*)(QA + 512 + 32);
    const bf16x8 qa2 = *(const bf16x8*)(QA + 1024), qb2 = *(const bf16x8*)(QA + 1024 + 32);
    auto rf0 = [&](int idx, int which) -> const float* {
        idx = idx > 128 + 7 ? 128 + 7 : idx;
        return idx < 128 ? p.cache_a0 + ((size_t)(bd * 128 + idx) * 2 + which) * 512 + head * 64
                         : p.out + O_A1S + ((size_t)(bd * 128 + idx - 8) * 2 + which) * 512 + head * 64;
    };
    auto rf1 = [&](int idx, int which) -> const float* {
        idx = idx > 512 + 7 ? 512 + 7 : idx;
        return idx < 512 ? p.cache_a1 + ((size_t)(bd * 512 + idx) * 2 + which) * 512 + head * 64
                         : p.out + O_A2S + ((size_t)(bd * 512 + idx - 8) * 2 + which) * 512 + head * 64;
    };
    auto rf2 = [&](int kk, int which) -> const float* {
        int j = kk >> 3; j = j > 128 ? 128 : j;
        const int idx = 2048 + (kk & 7) - 16 * j;
        return idx < 2048 ? p.cache_a2 + ((size_t)(bd * 2048 + idx) * 2 + which) * 512 + head * 64
                          : p.out + O_A3S + ((size_t)(bd * 2048 + idx - 8) * 2 + which) * 512 + head * 64;
    };
    KVf32<decltype(rf0)> kv0{rf0, Q};
    KVf32<decltype(rf1)> kv1{rf1, Q};
    KVf32<decltype(rf2)> kv2{rf2, Q};
#pragma unroll 1
    for (int i = wid; i < 55; i += 4) {
        if (i < 5) {
            attn_tile(qa0, qb0, kv0, 32 * i, [&](int k) { const int rel = 128 + s - k; return rowok && rel >= 0 && rel <= 128; }, m, l, o, c, Q);
        } else if (i < 22) {
            attn_tile(qa1, qb1, kv1, 32 * (i - 5), [&](int k) { const int rel = 512 + s - k; return rowok && rel >= 0 && rel <= 512 && (rel & 3) == 0; }, m, l, o, c, Q);
        } else {
            attn_tile(qa2, qb2, kv2, 32 * (i - 22), [&](int k) { return rowok && (k & 7) == s && (k >> 3) <= 128; }, m, l, o, c, Q);
        }
    }
    const float ls = row_sum(l);
    float* mb = (float*)smem + wid * (16 * 66);
    if (Q == 0) { mb[c * 66] = m; mb[c * 66 + 1] = ls; }
#pragma unroll
    for (int db = 0; db < 4; ++db)
#pragma unroll
        for (int j = 0; j < 4; ++j) mb[c * 66 + 2 + db * 16 + 4 * Q + j] = o[db][j];
    __syncthreads();
    if (wid == 0) {
        const float* m0 = (const float*)smem;
        float mw[4], Mx = NEG_INF;
#pragma unroll
        for (int w = 0; w < 4; ++w) { mw[w] = m0[w * (16 * 66) + c * 66]; Mx = fmaxf(Mx, mw[w]); }
        const float Mu = (Mx == NEG_INF) ? 0.f : Mx;
        float L = 0.f, sc[4];
#pragma unroll
        for (int w = 0; w < 4; ++w) { sc[w] = fexp2(mw[w] - Mu); L += m0[w * (16 * 66) + c * 66 + 1] * sc[w]; }
        if (rowok) {
            const float inv = 1.0f / L;
            bf16_t* OA = (bf16_t*)(p.ws + W_OA) + (size_t)trow * 512 + head * 64;
#pragma unroll
            for (int db = 0; db < 4; ++db) {
                float v[4];
#pragma unroll
                for (int j = 0; j < 4; ++j) {
                    float acc = 0.f;
#pragma unroll
                    for (int w = 0; w < 4; ++w) acc += m0[w * (16 * 66) + c * 66 + 2 + db * 16 + 4 * Q + j] * sc[w];
                    v[j] = acc * inv;
                }
                u32x2 wv; wv.x = pk2(v[0], v[1]); wv.y = pk2(v[2], v[3]);
                *(u32x2*)(OA + db * 16 + 4 * Q) = wv;
            }
        }
    }
    __syncthreads();
}
template <int REP> DI void phase_attnA(const Params& p, unsigned char* smem) {
    const int tid = otid(), lane = tid & 63;
    {
        unsigned* cnts = (unsigned*)(p.ws + W_CTL) + CTL_CNT_WORD + 64 * (7 + 8 * REP);
        int* sh_unit = (int*)(smem + 4 * 16 * 66 * 4);
        for (;;) {
            if (tid == 0) *sh_unit = (int)__hip_atomic_fetch_add(cnts, 1u, __ATOMIC_RELAXED, __HIP_MEMORY_SCOPE_AGENT);
            __syncthreads();
            const int u = __builtin_amdgcn_readfirstlane(*sh_unit);
            __syncthreads();
            if (u >= BD * 8) break;
            if (!(REP && PROBE_NSA_ONLY == 2)) attnA_sample_block(p, u, smem, tid);
        }
    }
    unsigned* cnt = (unsigned*)(p.ws + W_CTL) + CTL_CNT_WORD + 64 * (0 + 8 * REP);
    const int NPU = NBP * 8 * 32 * 16;
    for (;;) {
        const int u = wave_next(cnt, lane);
        if (u >= NPU) break;
        if (REP && PROBE_NSA_ONLY == 1) break;
        attnA_prompt_unit(p, u, lane);
    }
}

DI void top16_128(float (&v)[8], int c, float& outv, int& outi) {
    outv = NEG_INF; outi = 0;
    for (int it = 0; it < 16; ++it) {
        float bv = v[0]; int bi = c;
#pragma unroll
        for (int i = 1; i < 8; ++i) if (v[i] > bv) { bv = v[i]; bi = i * 16 + c; }
#pragma unroll
        for (int off = 1; off < 16; off <<= 1) {
            const float ov = __shfl_xor(bv, off); const int oi = __shfl_xor(bi, off);
            if (ov > bv || (ov == bv && oi < bi)) { bv = ov; bi = oi; }
        }
        if (c == it) { outv = bv; outi = bi; }
#pragma unroll
        for (int i = 0; i < 8; ++i) if (bi == i * 16 + c) v[i] = NEG_INF;
    }
}
DI unsigned umax(unsigned a, unsigned b) { return a > b ? a : b; }
DI unsigned dpp_max16(unsigned v) {
    v = umax(v, (unsigned)__builtin_amdgcn_update_dpp(0, (int)v, 0x121, 0xf, 0xf, true));
    v = umax(v, (unsigned)__builtin_amdgcn_update_dpp(0, (int)v, 0x122, 0xf, 0xf, true));
    v = umax(v, (unsigned)__builtin_amdgcn_update_dpp(0, (int)v, 0x124, 0xf, 0xf, true));
    v = umax(v, (unsigned)__builtin_amdgcn_update_dpp(0, (int)v, 0x128, 0xf, 0xf, true));
    return v;
}
DI float dpp_sum16(float v) {
    v += __builtin_bit_cast(float, __builtin_amdgcn_update_dpp(0, __builtin_bit_cast(int, v), 0x121, 0xf, 0xf, true));
    v += __builtin_bit_cast(float, __builtin_amdgcn_update_dpp(0, __builtin_bit_cast(int, v), 0x122, 0xf, 0xf, true));
    v += __builtin_bit_cast(float, __builtin_amdgcn_update_dpp(0, __builtin_bit_cast(int, v), 0x124, 0xf, 0xf, true));
    v += __builtin_bit_cast(float, __builtin_amdgcn_update_dpp(0, __builtin_bit_cast(int, v), 0x128, 0xf, 0xf, true));
    return v;
}
DI unsigned f2ord(float f) { const unsigned u = __float_as_uint(f); return (u & 0x80000000u) ? ~u : (u | 0x80000000u); }
DI float ord2f(unsigned o) { return __uint_as_float((o & 0x80000000u) ? (o & 0x7fffffffu) : ~o); }
DI unsigned umin(unsigned a, unsigned b) { return a < b ? a : b; }
DI unsigned top16_keys(unsigned (&k)[8], int c) {
#define CSWAP(i, j) { const unsigned hi_ = umax(k[i], k[j]), lo_ = umin(k[i], k[j]); k[i] = hi_; k[j] = lo_; }
    CSWAP(0, 1) CSWAP(2, 3) CSWAP(4, 5) CSWAP(6, 7)
    CSWAP(0, 2) CSWAP(1, 3) CSWAP(4, 6) CSWAP(5, 7)
    CSWAP(1, 2) CSWAP(5, 6)
    CSWAP(0, 4) CSWAP(1, 5) CSWAP(2, 6) CSWAP(3, 7)
    CSWAP(2, 4) CSWAP(3, 5)
    CSWAP(1, 2) CSWAP(3, 4) CSWAP(5, 6)
#undef CSWAP
    unsigned mine = 0u;
    for (int it = 0; it < 16; ++it) {
        const unsigned m = dpp_max16(k[0]);
        if (c == it) mine = m;
        const bool w = (k[0] == m);
#pragma unroll
        for (int i = 0; i < 7; ++i) k[i] = w ? k[i + 1] : k[i];
        k[7] = w ? 0u : k[7];
    }
    return mine;
}

DI void top16_keys2(unsigned (&ka)[8], unsigned (&kb)[8], int c, unsigned& ma, unsigned& mb) {
#define CSWAP2(i, j) { const unsigned ha_ = umax(ka[i], ka[j]), la_ = umin(ka[i], ka[j]); ka[i] = ha_; ka[j] = la_; \
                       const unsigned hb_ = umax(kb[i], kb[j]), lb_ = umin(kb[i], kb[j]); kb[i] = hb_; kb[j] = lb_; }
    CSWAP2(0, 1) CSWAP2(2, 3) CSWAP2(4, 5) CSWAP2(6, 7)
    CSWAP2(0, 2) CSWAP2(1, 3) CSWAP2(4, 6) CSWAP2(5, 7)
    CSWAP2(1, 2) CSWAP2(5, 6)
    CSWAP2(0, 4) CSWAP2(1, 5) CSWAP2(2, 6) CSWAP2(3, 7)
    CSWAP2(2, 4) CSWAP2(3, 5)
    CSWAP2(1, 2) CSWAP2(3, 4) CSWAP2(5, 6)
#undef CSWAP2
    ma = 0u; mb = 0u;
    for (int it = 0; it < 16; ++it) {
        const unsigned xa = dpp_max16(ka[0]), xb = dpp_max16(kb[0]);
        if (c == it) { ma = xa; mb = xb; }
        const bool wa = (ka[0] == xa), wb = (kb[0] == xb);
#pragma unroll
        for (int i = 0; i < 7; ++i) { ka[i] = wa ? ka[i + 1] : ka[i]; kb[i] = wb ? kb[i + 1] : kb[i]; }
        ka[7] = wa ? 0u : ka[7]; kb[7] = wb ? 0u : kb[7];
    }
}

template <int LAYER, int REP> DI void phase_peerA(const Params& p, unsigned char* smem) {
    unsigned char* ws = p.ws;
    const int tid = otid(), lane = tid & 63, wid = tid >> 6, c = lane & 15, Q = lane >> 4;
    unsigned char* wl = smem + 65536 + wid * 1024;
    float* ls1 = (float*)(wl) + Q * 16;
    int* li1 = (int*)(wl + 256) + Q * 16;
    float* lbs = (float*)(wl + 512) + Q * 16;
    int* le = (int*)(wl + 768) + Q * 16;
    const bf16_t* QH = (const bf16_t*)(ws + W_QH);
    {
        const u32x4* src = (const u32x4*)((const bf16_t*)(ws + W_SUBK) + (size_t)LAYER * 2 * 128 * 128);
        u32x4* dst = (u32x4*)smem;
#pragma unroll 4
        for (int i = tid; i < 4096; i += NTHREADS) dst[i] = src[i];
        __syncthreads();
    }
    const bf16_t* SUBK = (const bf16_t*)smem;
    const float* SU = (const float*)(ws + W_SU) + LAYER * NEXP;
    const float* SV = (const float*)(ws + W_SV) + LAYER * NEXP;
    unsigned short* SELE = (unsigned short*)(ws + W_SELE);
    float* SELG = (float*)(ws + W_SELG);
    float* SELU = (float*)(ws + W_SELU);
    unsigned* cnt = (unsigned*)(ws + W_CTL) + CTL_CNT_WORD + 64 * (1 + LAYER + 8 * REP);
    for (;;) {
        const int u = wave_next(cnt, lane);
        if (u >= (M / 16) * 8) break;
        const int row0 = (u >> 3) * 16, h = u & 7;
        f32x4 sc[2][8];
#pragma unroll
        for (int z = 0; z < 2; ++z)
#pragma unroll
            for (int nb = 0; nb < 8; ++nb) sc[z][nb] = (f32x4){0.f, 0.f, 0.f, 0.f};
#pragma unroll 1
        for (int ks = 0; ks < 4; ++ks)
#pragma unroll
            for (int z = 0; z < 2; ++z) {
                const bf16x8 a = *(const bf16x8*)(QH + ((size_t)((((row0 >> 4) * 8 + h) * 2 + z) * 4 + ks) * 64 + lane) * 8);
#pragma unroll
                for (int nb = 0; nb < 8; ++nb) {
                    const bf16x8 bq = *(const bf16x8*)(SUBK + ((size_t)((z * 8 + nb) * 4 + ks) * 64 + lane) * 8);
                    sc[z][nb] = MFMA16(a, bq, sc[z][nb]);
                }
            }
#pragma unroll
        for (int j = 0; j < 4; ++j) {
            const int row = row0 + Q * 4 + j;
            unsigned k0[8], k1[8];
#pragma unroll
            for (int nb = 0; nb < 8; ++nb) {
                k0[nb] = (f2ord(sc[0][nb][j]) & 0xffffff80u) | (unsigned)(127 - (nb * 16 + c));
                k1[nb] = (f2ord(sc[1][nb][j]) & 0xffffff80u) | (unsigned)(127 - (nb * 16 + c));
            }
            unsigned m0, m1;
            top16_keys2(k0, k1, c, m0, m1);
            const float s0 = ord2f(m0 & 0xffffff80u); const int i0 = 127 - (int)(m0 & 127u);
            ls1[c] = ord2f(m1 & 0xffffff80u); li1[c] = 127 - (int)(m1 & 127u);
            wave_lds_sync();
            int pp = 0; float s1p = ls1[0]; int i1p = li1[0];
            for (int it = 0; it < 16; ++it) {
                const float cand = s0 + s1p;
                const unsigned key = (pp < 16) ? ((f2ord(cand) & 0xffffff00u) | (unsigned)(255 - (c * 16 + pp))) : 0u;
                const unsigned mk = dpp_max16(key);
                if (key == mk) {
                    le[it] = i0 * 128 + i1p; lbs[it] = cand;
                    ++pp; s1p = ls1[pp & 15]; i1p = li1[pp & 15];
                }
            }
            wave_lds_sync();
            const int e = le[c];
            const float ex = __expf(lbs[c] - lbs[0]);
            const float sm = dpp_sum16(ex);
            const size_t o = (size_t)row * 128 + h * 16 + c;
            SELE[o] = (unsigned short)e;
            SELG[o] = ex / sm * SV[e];
            SELU[o] = SU[e];
            wave_lds_sync();
        }
    }
    __syncthreads();
}

template <int LAYER, int REP> DI void phase_peerB(const Params& p, unsigned char* smem) {
    constexpr bool DRY = REP != 0;
    unsigned char* ws = p.ws;
    const int tid = otid(), lane = tid & 63, wid = tid >> 6, c = lane & 15, Q = lane >> 4;
    unsigned char* xq = smem + wid * 1024;
    const unsigned char* U8 = ws + W_U8 + (size_t)LAYER * NEXP * 1024;
    const unsigned char* V8 = ws + W_V8 + (size_t)LAYER * NEXP * 1024;
    const bf16_t* XH = (const bf16_t*)(ws + W_XHAT);
    float* XR = (float*)(ws + W_XR);
    const unsigned short* SELE = (const unsigned short*)(ws + W_SELE);
    const float* SELG = (const float*)(ws + W_SELG);
    const float* SELU = (const float*)(ws + W_SELU);
    unsigned* cnt = (unsigned*)(ws + W_CTL) + CTL_CNT_WORD + 64 * (5 + LAYER + 8 * REP);
    for (;;) {
        const int row = wave_next(cnt, lane);
        if (row >= M) break;
        const int eA = (int)SELE[(size_t)row * 128 + lane], eB = (int)SELE[(size_t)row * 128 + 64 + lane];
        const float gA = SELG[(size_t)row * 128 + lane], gB = SELG[(size_t)row * 128 + 64 + lane];
        const float uA = SELU[(size_t)row * 128 + lane], uB = SELU[(size_t)row * 128 + 64 + lane];
        const float xs = ((const float*)(ws + W_SA))[row];
        *(u32x4*)(xq + lane * 16) = *(const u32x4*)(ws + W_XQ + (size_t)row * D + lane * 16);
        wave_lds_sync();
        float w[8][4];
        i32x4 uf[16];
        {
            const int ec0 = __shfl(eA, c);
            const unsigned char* ur = U8 + (size_t)ec0 * 1024 + Q * 16;
#pragma unroll
            for (int ks = 0; ks < 16; ++ks) uf[ks] = *(const i32x4*)(ur + ks * 64);
        }
#pragma unroll
        for (int G = 0; G < 8; ++G) {
            float su4[4], g4[4];
            {
                const int src = (G & 3) * 16 + 4 * Q;
#pragma unroll
                for (int j = 0; j < 4; ++j) { g4[j] = __shfl(G < 4 ? gA : gB, src + j); su4[j] = __shfl(G < 4 ? uA : uB, src + j); }
            }
            i32x4 di = {0, 0, 0, 0};
#pragma unroll
            for (int kq = 0; kq < 4; ++kq) {
                i32x4 xb[4];
#pragma unroll
                for (int k2 = 0; k2 < 4; ++k2) xb[k2] = *(const i32x4*)(xq + (kq * 4 + k2) * 64 + Q * 16);
#pragma unroll
                for (int k2 = 0; k2 < 4; ++k2) di = MFMA_I8(uf[kq * 4 + k2], xb[k2], di);
                __builtin_amdgcn_sched_barrier(0);
            }
            if (G < 7) {
                const int ecn = __shfl((G + 1) < 4 ? eA : eB, ((G + 1) & 3) * 16 + c);
                const unsigned char* ur = U8 + (size_t)ecn * 1024 + Q * 16;
#pragma unroll
                for (int ks = 0; ks < 16; ++ks) uf[ks] = *(const i32x4*)(ur + ks * 64);
            }
#pragma unroll
            for (int j = 0; j < 4; ++j) w[G][j] = g4[j] * gelu_tanh((float)di[j] * su4[j] * xs);
            __builtin_amdgcn_sched_barrier(0);
        }
        float wmax = 0.f;
#pragma unroll
        for (int G = 0; G < 8; ++G)
#pragma unroll
            for (int j = 0; j < 4; ++j) wmax = fmaxf(wmax, fabsf(w[G][j]));
        wmax = fmaxf(wmax, __shfl_xor(wmax, 16)); wmax = fmaxf(wmax, __shfl_xor(wmax, 32));
        const float winv = wmax > 0.f ? 127.0f / wmax : 0.f;
        int wq[8];
#pragma unroll
        for (int G = 0; G < 8; ++G) {
            const int q0 = (int)rintf(w[G][0] * winv), q1 = (int)rintf(w[G][1] * winv), q2 = (int)rintf(w[G][2] * winv), q3 = (int)rintf(w[G][3] * winv);
            wq[G] = (int)((unsigned)(q0 & 255) | ((unsigned)(q1 & 255) << 8) | ((unsigned)(q2 & 255) << 16) | ((unsigned)(q3 & 255) << 24));
        }
        int ai[16];
#pragma unroll
        for (int i = 0; i < 16; ++i) ai[i] = 0;
        i32x4 VA[4], VB[4];
#define PB_VLOAD(V, grp) { _Pragma("unroll") for (int j_ = 0; j_ < 4; ++j_) { \
            const int es_ = __builtin_amdgcn_readlane(((grp) >> 2) < 4 ? eA : eB, ((((grp) >> 2) & 3) * 16 + ((grp) & 3) * 4 + j_)); \
            V[j_] = *(const i32x4*)(V8 + (size_t)es_ * 1024 + lane * 16); } }
#define PB_VDOT(V, grp) { const int wd_ = __builtin_amdgcn_readlane(wq[(grp) >> 2], 16 * ((grp) & 3)); \
            _Pragma("unroll") for (int i_ = 0; i_ < 4; ++i_) { \
                const unsigned A_ = (unsigned)V[0][i_], B_ = (unsigned)V[1][i_], C_ = (unsigned)V[2][i_], D_ = (unsigned)V[3][i_]; \
                const unsigned P0_ = __builtin_amdgcn_perm(B_, A_, 0x05010400u), P2_ = __builtin_amdgcn_perm(B_, A_, 0x07030602u); \
                const unsigned Q0_ = __builtin_amdgcn_perm(D_, C_, 0x05010400u), Q2_ = __builtin_amdgcn_perm(D_, C_, 0x07030602u); \
                ai[4 * i_ + 0] = __builtin_amdgcn_sdot4((int)__builtin_amdgcn_perm(Q0_, P0_, 0x05040100u), wd_, ai[4 * i_ + 0], false); \
                ai[4 * i_ + 1] = __builtin_amdgcn_sdot4((int)__builtin_amdgcn_perm(Q0_, P0_, 0x07060302u), wd_, ai[4 * i_ + 1], false); \
                ai[4 * i_ + 2] = __builtin_amdgcn_sdot4((int)__builtin_amdgcn_perm(Q2_, P2_, 0x05040100u), wd_, ai[4 * i_ + 2], false); \
                ai[4 * i_ + 3] = __builtin_amdgcn_sdot4((int)__builtin_amdgcn_perm(Q2_, P2_, 0x07060302u), wd_, ai[4 * i_ + 3], false); } }
        PB_VLOAD(VA, 0);
#pragma unroll
        for (int grp = 0; grp < 32; grp += 2) {
            PB_VLOAD(VB, grp + 1);
            PB_VDOT(VA, grp);
            if (grp + 2 < 32) PB_VLOAD(VA, grp + 2);
            PB_VDOT(VB, grp + 1);
        }
#undef PB_VLOAD
#undef PB_VDOT
        float acc[16];
        {
            const float ws_ = wmax * (1.0f / 127.0f);
#pragma unroll
            for (int i = 0; i < 16; ++i) acc[i] = (float)ai[i] * ws_;
        }
        const float wsum = 0.f;
        float* xr = XR + (size_t)row * D + lane * 16;
        float* xw = DRY ? (float*)(ws + W_END) + (size_t)row * D + lane * 16 : xr;
        float x[16]; float ss = 0.f;
#pragma unroll
        for (int i = 0; i < 4; ++i) { const float4 t = ((const float4*)xr)[i]; x[4 * i] = t.x; x[4 * i + 1] = t.y; x[4 * i + 2] = t.z; x[4 * i + 3] = t.w; }
#pragma unroll
        for (int i = 0; i < 16; ++i) { x[i] += acc[i] - 128.0f * wsum; ss += x[i] * x[i]; }
        ss = wave_sum(ss);
        const float rs = rsqrtf(ss * (1.0f / D) + 1e-6f);
        if (LAYER == 0) {
#pragma unroll
            for (int i = 0; i < 4; ++i) ((float4*)xw)[i] = make_float4(x[4 * i], x[4 * i + 1], x[4 * i + 2], x[4 * i + 3]);
            float am = 0.f;
#pragma unroll
            for (int i = 0; i < 16; ++i) am = fmaxf(am, fabsf(x[i]));
#pragma unroll
            for (int off = 32; off >= 1; off >>= 1) am = fmaxf(am, __shfl_xor(am, off));
            const float inv = am > 0.f ? 127.0f / am : 0.f;
            u32x4 o;
#pragma unroll
            for (int i = 0; i < 4; ++i) {
                const int q0 = (int)rintf(x[4 * i] * inv), q1 = (int)rintf(x[4 * i + 1] * inv), q2 = (int)rintf(x[4 * i + 2] * inv), q3 = (int)rintf(x[4 * i + 3] * inv);
                o[i] = (unsigned)(q0 & 255) | ((unsigned)(q1 & 255) << 8) | ((unsigned)(q2 & 255) << 16) | ((unsigned)(q3 & 255) << 24);
            }
            *(u32x4*)(ws + (DRY ? W_END + (size_t)M * D * 4 : W_XQ) + (size_t)row * D + lane * 16) = o;
            if (lane == 0 && !DRY) ((float*)(ws + W_SA))[row] = rs * am * (1.0f / 127.0f);
        } else {
            float* y = DRY ? xw : (row < MP ? p.out + O_YP + (size_t)row * D : p.out + O_YS + (size_t)(row - MP) * D) + lane * 16;
            const float4* gf = (const float4*)(p.g_final + lane * 16);
#pragma unroll
            for (int i = 0; i < 4; ++i) { const float4 g = gf[i];
                ((float4*)y)[i] = make_float4(x[4 * i] * rs * g.x, x[4 * i + 1] * rs * g.y, x[4 * i + 2] * rs * g.z, x[4 * i + 3] * rs * g.w); }
        }
        wave_lds_sync();
    }
}

constexpr int CW_LD = 264;
constexpr int CW_TILE = 64 * CW_LD;
template <int REP> DI void phase_compress(const Params& p, unsigned char* smem) {
    unsigned char* ws = p.ws;
    const int tid = otid(), lane = tid & 63, wid = tid >> 6, c = lane & 15, Q = lane >> 4;
    bf16_t* Wl = (bf16_t*)smem;
    int* sh_unit = (int*)(smem + 2 * CW_TILE * 2);
    unsigned* cnt = (unsigned*)(ws + W_CTL) + CTL_CNT_WORD + 64 * (3 + 8 * REP);
    const float* pet = (const float*)(ws + W_PET);
    const float2* tab = (const float2*)(ws + W_ROPE);
    const int NU = 34 * 4 * 2 * 9;
    const int wf = tid >> 2, wpart = (tid & 3) * 64;
    for (;;) {
        if (tid == 0) *sh_unit = (int)__hip_atomic_fetch_add(cnt, 1u, __ATOMIC_RELAXED, __HIP_MEMORY_SCOPE_AGENT);
        __syncthreads();
        const int u = __builtin_amdgcn_readfirstlane(*sh_unit);
        __syncthreads();
        if (u >= NU) break;
        const int u9 = u / 9, wv = (u - u9 * 9) * 4 + wid, z = u9 & 1, kvh = (u9 >> 1) & 3, bo = u9 >> 3;
        const int bb = bo < 32 ? bo + 2 : bo - 32;
        int blk = wv * 15 + c;
        const bool colok = (c < 15) && (blk < 511);
        blk = blk > 511 ? 511 : blk;
        const bf16_t* W1 = (const bf16_t*)(ws + W_WC1) + (size_t)z * 64 * 2048;
        const bf16_t* W2 = (const bf16_t*)(ws + W_WC2) + (size_t)z * 4096;
        f32x4 hid[4];
#pragma unroll
        for (int i = 0; i < 4; ++i) hid[i] = (f32x4){0.f, 0.f, 0.f, 0.f};
        bf16x8 wr[8];
#define W_LOAD(g) { _Pragma("unroll") for (int i_ = 0; i_ < 8; ++i_) wr[i_] = *(const bf16x8*)(W1 + (size_t)wf * 2048 + (g) * 256 + wpart + i_ * 8); }
#define W_STORE(buf) { _Pragma("unroll") for (int i_ = 0; i_ < 8; ++i_) *(bf16x8*)&Wl[(buf) * CW_TILE + wf * CW_LD + wpart + i_ * 8] = wr[i_]; }
#define C_MMA(BF, u_, h_, buf) { const bf16x8 bq_ = (BF); _Pragma("unroll") for (int fb = 0; fb < 4; ++fb) \
            hid[fb] = MFMA16(*(const bf16x8*)&Wl[(buf) * CW_TILE + (fb * 16 + c) * CW_LD + ((u_) * 2 + (h_)) * 32 + Q * 8], bq_, hid[fb]); }
        if (bb < 2) {
            const bf16_t* src = (const bf16_t*)(ws + (z == 0 ? W_CMPK : W_CMPV));
            bf16x8 E0[4][2], E1[4][2];
#define E_LOAD(E, g) { _Pragma("unroll") for (int u_ = 0; u_ < 4; ++u_) { int t_ = blk * 16 + (g) * 4 + u_; t_ = t_ > SEQ - 1 ? SEQ - 1 : t_; \
                const bf16_t* r_ = src + ((size_t)(bb * SEQ + t_) * 4 + kvh) * 64 + Q * 8; E[u_][0] = *(const bf16x8*)r_; E[u_][1] = *(const bf16x8*)(r_ + 32); } }
#define E_STEP(G, Ec, En) { const int g_ = (G); if (g_ + 1 < 8) { W_LOAD(g_ + 1); E_LOAD(En, g_ + 1); } \
                _Pragma("unroll") for (int u_ = 0; u_ < 4; ++u_) { C_MMA(Ec[u_][0], u_, 0, g_ & 1); C_MMA(Ec[u_][1], u_, 1, g_ & 1); } \
                if (g_ + 1 < 8) W_STORE((g_ + 1) & 1); lds_barrier(); }
            W_LOAD(0); E_LOAD(E0, 0); W_STORE(0); lds_barrier();
#pragma unroll 1
            for (int g = 0; g < 8; g += 2) { E_STEP(g, E0, E1); E_STEP(g + 1, E1, E0); }
#undef E_LOAD
#undef E_STEP
        } else {
            const int bd = bb - 2;
            const int* pt = p.page_table + bd * NPAGE;
            const int pg0 = pt[(blk * 16) >> 7];
            const int wr_ = (tid & 3) >> 1, wh_ = tid & 1;
            float4 D0[2][4], D1[2][4];
#define W_LOAD2(g) { _Pragma("unroll") for (int i_ = 0; i_ < 8; ++i_) wr[i_] = *(const bf16x8*)(W1 + (size_t)wf * 2048 + (wh_ * 16 + 2 * (g) + wr_) * 64 + i_ * 8); }
#define D_LOAD2(D, g) { _Pragma("unroll") for (int r_ = 0; r_ < 2; ++r_) { \
                const int l_ = 2 * (g) + r_; \
                const float* p_ = p.cache_b_kv + ((size_t)(pg0 * 128 + ((blk * 16 + l_) & 127)) * 4 + z) * 256 + kvh * 64 + Q * 8; \
                D[r_][0] = *(const float4*)p_; D[r_][1] = *(const float4*)(p_ + 4); D[r_][2] = *(const float4*)(p_ + 32); D[r_][3] = *(const float4*)(p_ + 36); \
} }
#define C_MMA2(BF, koff, buf) { const bf16x8 bq_ = (BF); _Pragma("unroll") for (int fb = 0; fb < 4; ++fb) \
            hid[fb] = MFMA16(*(const bf16x8*)&Wl[(buf) * CW_TILE + (fb * 16 + c) * CW_LD + (koff) + Q * 8], bq_, hid[fb]); }
#define D_STEP2(G, Dc, Dn) { const int g_ = (G); if (g_ + 1 < 8) { W_LOAD2(g_ + 1); D_LOAD2(Dn, g_ + 1); } \
                _Pragma("unroll") for (int r_ = 0; r_ < 2; ++r_) _Pragma("unroll") for (int kc_ = 0; kc_ < 2; ++kc_) { \
                    const bf16x8 lo_ = pack8(Dc[r_][2 * kc_].x, Dc[r_][2 * kc_].y, Dc[r_][2 * kc_].z, Dc[r_][2 * kc_].w, Dc[r_][2 * kc_ + 1].x, Dc[r_][2 * kc_ + 1].y, Dc[r_][2 * kc_ + 1].z, Dc[r_][2 * kc_ + 1].w); \
                    const u32x4 lw_ = __builtin_bit_cast(u32x4, lo_); u32x4 hw_; \
                    hw_.x = (unsigned)__shfl((int)lw_.x, lane + 1); hw_.y = (unsigned)__shfl((int)lw_.y, lane + 1); hw_.z = (unsigned)__shfl((int)lw_.z, lane + 1); hw_.w = (unsigned)__shfl((int)lw_.w, lane + 1); \
                    C_MMA2(lo_, (r_ * 2 + 0) * 64 + kc_ * 32, g_ & 1); \
                    C_MMA2(__builtin_bit_cast(bf16x8, hw_), (r_ * 2 + 1) * 64 + kc_ * 32, g_ & 1); } \
                if (g_ + 1 < 8) W_STORE((g_ + 1) & 1); lds_barrier(); }
            W_LOAD2(0); D_LOAD2(D0, 0); W_STORE(0); lds_barrier();
#pragma unroll 1
            for (int g = 0; g < 8; g += 2) { D_STEP2(g, D0, D1); D_STEP2(g + 1, D1, D0); }
#undef W_LOAD2
#undef D_LOAD2
#undef C_MMA2
#undef D_STEP2
        }
#undef W_LOAD
#undef W_STORE
#undef C_MMA
#pragma unroll
        for (int fb = 0; fb < 4; ++fb)
#pragma unroll
            for (int j = 0; j < 4; ++j) hid[fb][j] = gelu_tanh(hid[fb][j] + pet[z * 64 + fb * 16 + 4 * Q + j]);
        f32x4 ot[4];
#pragma unroll
        for (int i = 0; i < 4; ++i) ot[i] = (f32x4){0.f, 0.f, 0.f, 0.f};
#pragma unroll
        for (int kb = 0; kb < 2; ++kb) {
            const bf16x8 hb = pack8(hid[2 * kb][0], hid[2 * kb][1], hid[2 * kb][2], hid[2 * kb][3], hid[2 * kb + 1][0], hid[2 * kb + 1][1], hid[2 * kb + 1][2], hid[2 * kb + 1][3]);
#pragma unroll
            for (int db = 0; db < 4; ++db) {
                const bf16x4 lo = *(const bf16x4*)(W2 + (size_t)(db * 16 + c) * 64 + kb * 32 + 4 * Q);
                const bf16x4 hi = *(const bf16x4*)(W2 + (size_t)(db * 16 + c) * 64 + kb * 32 + 16 + 4 * Q);
                const bf16x8 a = __builtin_shufflevector(lo, hi, 0, 1, 2, 3, 4, 5, 6, 7);
                ot[db] = MFMA16(a, hb, ot[db]);
            }
        }
        if (z == 0) {
            const int pos = blk * 16 + 31;
#pragma unroll
            for (int j = 0; j < 4; ++j) {
                const float partner = __shfl_xor(ot[0][j], 32);
                const int pc = pos > 8199 ? 8199 : pos;
                const float2 cs = tab[pc * 8 + ((4 * Q + j) & 7)];
                ot[0][j] = (Q < 2) ? ot[0][j] * cs.x - partner * cs.y : ot[0][j] * cs.x + partner * cs.y;
            }
            if (colok) {
                bf16_t* KC = (bf16_t*)(ws + W_KC) + ((size_t)(bb * 4 + kvh) * 512 + blk) * 64;
#pragma unroll
                for (int db = 0; db < 4; ++db) { u32x2 w; w.x = pk2(ot[db][0], ot[db][1]); w.y = pk2(ot[db][2], ot[db][3]); *(u32x2*)(KC + db * 16 + 4 * Q) = w; }
            }
        } else if (colok) {
            bf16_t* VCT = (bf16_t*)(ws + W_VCT) + (size_t)(bb * 4 + kvh) * 64 * 512;
#pragma unroll
            for (int db = 0; db < 4; ++db)
#pragma unroll
                for (int j = 0; j < 4; ++j) VCT[(size_t)(db * 16 + 4 * Q + j) * 512 + blk] = (bf16_t)f2bf(ot[db][j]);
        }
    }
}

constexpr int KT_LD = 72;
constexpr int KT_ELEMS = 64 * KT_LD;
struct TileRegsBf { bf16x8 k0, k1, v0, v1; };
struct TileRegsF { float4 k[4], v[4]; };

DI void attn_tile64(const bf16x8& q0, const bf16x8& q1, const bf16_t* Kl, const bf16_t* VTl, int key0, bool rowok, int klo, int khi,
                    float& m, float& l, f32x4 (&o)[4], int c, int Q) {
    const float ninit = rowok ? -m : NEG_INF;
    f32x4 s[4];
#pragma unroll
    for (int sub = 0; sub < 4; ++sub) {
        s[sub] = (f32x4){ninit, ninit, ninit, ninit};
        s[sub] = MFMA16(*(const bf16x8*)&Kl[(sub * 16 + c) * KT_LD + Q * 8], q0, s[sub]);
        s[sub] = MFMA16(*(const bf16x8*)&Kl[(sub * 16 + c) * KT_LD + 32 + Q * 8], q1, s[sub]);
    }
    if (__any(rowok && (key0 < klo || key0 + 63 > khi))) {
        const unsigned span = (unsigned)(khi - klo);
        const int kb = key0 + 4 * Q - klo;
#pragma unroll
        for (int sub = 0; sub < 4; ++sub)
#pragma unroll
            for (int j = 0; j < 4; ++j) if ((unsigned)(kb + sub * 16 + j) > span) s[sub][j] = NEG_INF;
    }
    float mx = fmaxf(fmaxf(fmaxf(s[0][0], s[0][1]), fmaxf(s[0][2], s[0][3])), fmaxf(fmaxf(s[1][0], s[1][1]), fmaxf(s[1][2], s[1][3])));
    mx = fmaxf(mx, fmaxf(fmaxf(fmaxf(s[2][0], s[2][1]), fmaxf(s[2][2], s[2][3])), fmaxf(fmaxf(s[3][0], s[3][1]), fmaxf(s[3][2], s[3][3]))));
    if (__any(mx > LAZY_T)) {
        float mr = mx + m;
        mr = fmaxf(mr, __shfl_xor(mr, 16)); mr = fmaxf(mr, __shfl_xor(mr, 32));
        const float mn = fmaxf(m, mr);
        const float shift = mn - m;
        const float alpha = fexp2(-shift);
        l *= alpha; m = mn;
#pragma unroll
        for (int db = 0; db < 4; ++db) o[db] = o[db] * alpha;
#pragma unroll
        for (int sub = 0; sub < 4; ++sub)
#pragma unroll
            for (int j = 0; j < 4; ++j) s[sub][j] -= shift;
    }
#pragma unroll
    for (int sub = 0; sub < 4; ++sub)
#pragma unroll
        for (int j = 0; j < 4; ++j) { s[sub][j] = fexp2(s[sub][j]); l += s[sub][j]; }
#pragma unroll
    for (int half = 0; half < 2; ++half) {
        const bf16x8 pb = pack8(s[2 * half][0], s[2 * half][1], s[2 * half][2], s[2 * half][3], s[2 * half + 1][0], s[2 * half + 1][1], s[2 * half + 1][2], s[2 * half + 1][3]);
#pragma unroll
        for (int db = 0; db < 4; ++db) {
            const bf16x4 lo = *(const bf16x4*)&VTl[(db * 16 + c) * KT_LD + half * 32 + 4 * Q];
            const bf16x4 hi = *(const bf16x4*)&VTl[(db * 16 + c) * KT_LD + half * 32 + 16 + 4 * Q];
            o[db] = MFMA16(__builtin_shufflevector(lo, hi, 0, 1, 2, 3, 4, 5, 6, 7), pb, o[db]);
        }
    }
}

struct SrcBf {
    const bf16_t* K; const bf16_t* VT; int ldv;
    typedef TileRegsBf Regs;
    DI void load(Regs& r, int key0, int tid, bool needv) const {
        const int i0 = tid, i1 = tid + 256;
        r.k0 = *(const bf16x8*)(K + (size_t)(key0 + (i0 >> 3)) * 64 + (i0 & 7) * 8);
        r.k1 = *(const bf16x8*)(K + (size_t)(key0 + (i1 >> 3)) * 64 + (i1 & 7) * 8);
        if (needv) {
            r.v0 = *(const bf16x8*)(VT + (size_t)(i0 >> 3) * ldv + key0 + (i0 & 7) * 8);
            r.v1 = *(const bf16x8*)(VT + (size_t)(i1 >> 3) * ldv + key0 + (i1 & 7) * 8);
        }
    }
    DI void store(const Regs& r, bf16_t* Kl, bf16_t* VTl, int tid, bool needv) const {
        const int i0 = tid, i1 = tid + 256;
        *(bf16x8*)&Kl[(i0 >> 3) * KT_LD + (i0 & 7) * 8] = r.k0;
        *(bf16x8*)&Kl[(i1 >> 3) * KT_LD + (i1 & 7) * 8] = r.k1;
        if (needv) {
            *(bf16x8*)&VTl[(i0 >> 3) * KT_LD + (i0 & 7) * 8] = r.v0;
            *(bf16x8*)&VTl[(i1 >> 3) * KT_LD + (i1 & 7) * 8] = r.v1;
        }
    }
};
template <class RowF> struct SrcF32 {
    RowF rf;
    typedef TileRegsF Regs;
    DI void load(Regs& r, int key0, int tid, bool needv) const {
        const int key = key0 + (tid >> 2), qd = (tid & 3) * 16;
        const float4* kp = (const float4*)(rf(key, 0) + qd);
#pragma unroll
        for (int i = 0; i < 4; ++i) r.k[i] = kp[i];
        if (needv) {
            const float4* vp = (const float4*)(rf(key, 1) + qd);
#pragma unroll
            for (int i = 0; i < 4; ++i) r.v[i] = vp[i];
        }
    }
    DI void store(const Regs& r, bf16_t* Kl, bf16_t* VTl, int tid, bool needv) const {
        const int kl = tid >> 2, qd = (tid & 3) * 16;
        u32x4 a, b2;
        a.x = pk2(r.k[0].x, r.k[0].y); a.y = pk2(r.k[0].z, r.k[0].w); a.z = pk2(r.k[1].x, r.k[1].y); a.w = pk2(r.k[1].z, r.k[1].w);
        b2.x = pk2(r.k[2].x, r.k[2].y); b2.y = pk2(r.k[2].z, r.k[2].w); b2.z = pk2(r.k[3].x, r.k[3].y); b2.w = pk2(r.k[3].z, r.k[3].w);
        *(u32x4*)&Kl[kl * KT_LD + qd] = a; *(u32x4*)&Kl[kl * KT_LD + qd + 8] = b2;
        if (needv) {
#pragma unroll
            for (int i = 0; i < 4; ++i) {
                VTl[(qd + 4 * i + 0) * KT_LD + kl] = (bf16_t)f2bf(r.v[i].x);
                VTl[(qd + 4 * i + 1) * KT_LD + kl] = (bf16_t)f2bf(r.v[i].y);
                VTl[(qd + 4 * i + 2) * KT_LD + kl] = (bf16_t)f2bf(r.v[i].z);
                VTl[(qd + 4 * i + 3) * KT_LD + kl] = (bf16_t)f2bf(r.v[i].w);
            }
        }
    }
};

struct LinIter { int k; DI int next() { const int r = k; k += 64; return r; } };
struct BitIter {
    unsigned r0, r1, r2, r3;
    DI int next() {
        int jb;
        if (r0) { jb = __builtin_ctz(r0); r0 &= r0 - 1; }
        else if (r1) { jb = 32 + __builtin_ctz(r1); r1 &= r1 - 1; }
        else if (r2) { jb = 64 + __builtin_ctz(r2); r2 &= r2 - 1; }
        else if (r3) { jb = 96 + __builtin_ctz(r3); r3 &= r3 - 1; }
        else jb = 128;
        return jb * 64;
    }
};
template <class Src, class Iter, class CompF>
DI void coop_tiles(const Src& src, int nsteps, bool needv, Iter it, CompF&& comp, bf16_t* Kl, bf16_t* VTl, int tid) {
    typename Src::Regs regs;
    int knext = 0;
    if (nsteps > 0) { knext = it.next(); src.load(regs, knext, tid, needv); src.store(regs, Kl, VTl, tid, needv); }
    lds_barrier();
    for (int s = 0; s < nsteps; ++s) {
        const int buf = s & 1, kcur = knext;
        if (s + 1 < nsteps) { knext = it.next(); src.load(regs, knext, tid, needv); }
        comp(s, kcur, Kl + buf * KT_ELEMS, VTl + buf * KT_ELEMS);
        if (s + 1 < nsteps) src.store(regs, Kl + (buf ^ 1) * KT_ELEMS, VTl + (buf ^ 1) * KT_ELEMS, tid, needv);
        lds_barrier();
    }
}
template <class Src, class Iter, class CompF>
DI void coop_tiles4(const Src& src, int nsteps, bool needv, Iter it, CompF&& comp, bf16_t* Kl, bf16_t* VTl, int tid) {
    typename Src::Regs R0, R1;
    int k0 = 0, k1 = 0;
    if (nsteps > 0) { k0 = it.next(); src.load(R0, k0, tid, needv); }
    if (nsteps > 1) { k1 = it.next(); src.load(R1, k1, tid, needv); }
    if (nsteps > 0) src.store(R0, Kl, VTl, tid, needv);
    lds_barrier();
#define CT4_STEP(S, Ra, ka, Rb) { const int s_ = (S); const int kcur_ = ka; \
        if (s_ + 2 < nsteps) { ka = it.next(); src.load(Ra, ka, tid, needv); } \
        comp(s_, kcur_, Kl + (s_ & 1) * KT_ELEMS, VTl + (s_ & 1) * KT_ELEMS); \
        if (s_ + 1 < nsteps) src.store(Rb, Kl + ((s_ + 1) & 1) * KT_ELEMS, VTl + ((s_ + 1) & 1) * KT_ELEMS, tid, needv); \
        lds_barrier(); }
    for (int s = 0; s < nsteps; s += 2) {
        CT4_STEP(s, R0, k0, R1);
        if (s + 1 < nsteps) CT4_STEP(s + 1, R1, k1, R0);
    }
#undef CT4_STEP
}

constexpr int ST2_BYTES = 4 * KT_ELEMS * 2;
template <class Src, class Iter, class CompF>
DI void coop_tiles2x(const Src& src, int ntiles, bool needv, Iter it, CompF&& comp, unsigned char* tiles, int tid) {
    typename Src::Regs RA, RB;
    int kA = 0, kB = 0;
    const int nst = (ntiles + 1) >> 1;
#define ST2_K(st, ab) ((bf16_t*)(tiles + (st) * ST2_BYTES) + (ab) * KT_ELEMS)
#define ST2_V(st, ab) ((bf16_t*)(tiles + (st) * ST2_BYTES) + (2 + (ab)) * KT_ELEMS)
    if (nst > 0) {
        kA = it.next(); src.load(RA, kA, tid, needv);
        if (ntiles > 1) { kB = it.next(); src.load(RB, kB, tid, needv); }
        src.store(RA, ST2_K(0, 0), ST2_V(0, 0), tid, needv);
        if (ntiles > 1) src.store(RB, ST2_K(0, 1), ST2_V(0, 1), tid, needv);
    }
    lds_barrier();
    for (int s = 0; s < nst; ++s) {
        const int cA = kA, cB = kB, st = s & 1;
        const bool vB = (2 * s + 1 < ntiles), more = (s + 1 < nst), nB = (2 * s + 3 < ntiles);
        if (more) { kA = it.next(); src.load(RA, kA, tid, needv); if (nB) { kB = it.next(); src.load(RB, kB, tid, needv); } }
        comp(2 * s, cA, ST2_K(st, 0), ST2_V(st, 0));
        if (vB) comp(2 * s + 1, cB, ST2_K(st, 1), ST2_V(st, 1));
        if (more) { src.store(RA, ST2_K(st ^ 1, 0), ST2_V(st ^ 1, 0), tid, needv); if (nB) src.store(RB, ST2_K(st ^ 1, 1), ST2_V(st ^ 1, 1), tid, needv); }
        lds_barrier();
    }
#undef ST2_K
#undef ST2_V
}

template <bool SAMPLE, int PV = 0> DI void nsa_block_unit(const Params& p, int unit, unsigned char* smem, int tid) {
    unsigned char* ws = p.ws;
    const int lane = tid & 63, wid = tid >> 6, c = lane & 15, Q = lane >> 4, qi = c >> 2, gq = c & 3;
    bf16_t* Kl = (bf16_t*)smem;
    bf16_t* VTl = Kl + 2 * KT_ELEMS;
    float* imp = (float*)(smem + 18432) + wid * 512;
    unsigned* msk = (unsigned*)(smem + 2 * ST2_BYTES) + wid * 16;
    unsigned* bun = (unsigned*)(smem + 2 * ST2_BYTES + 256);
    int b, kvh, t0blk;
    if (!SAMPLE) { t0blk = (511 - (unit & 511)) * 16; kvh = (unit >> 9) & 3; b = unit >> 11; }
    else { t0blk = 0; kvh = unit & 3; b = unit >> 2; }
    const bool wactive = SAMPLE ? (wid < 2) : true;
    const int qn = wactive ? wid * 4 + qi : qi;
    const int bb = SAMPLE ? 2 + b : b;
    const int qbase = SAMPLE ? PAST : t0blk;
    const int qpos = qbase + qn;
    const int qmax_blk = qbase + (SAMPLE ? 7 : 15);
    const int trow = SAMPLE ? MP + b * 8 + qn : b * SEQ + t0blk + qn;
    const int hq = kvh * 4 + gq;
    const bf16_t* qp = (const bf16_t*)(ws + W_QB) + (size_t)trow * 1024 + hq * 64 + Q * 8;
    const bf16x8 q0 = *(const bf16x8*)qp, q1 = *(const bf16x8*)(qp + 32);
    const float* gp = (const float*)(ws + W_GATE) + (size_t)trow * 48 + hq * 3;
    const float g_c = gp[0], g_s = gp[1], g_w = gp[2];
    f32x4 outacc[4], o[4];
#pragma unroll
    for (int i = 0; i < 4; ++i) { outacc[i] = (f32x4){0.f, 0.f, 0.f, 0.f}; o[i] = (f32x4){0.f, 0.f, 0.f, 0.f}; }
    float m = 0.f, l = 0.f;
    const int nhi = (qpos - 31) >> 4;
    SrcBf srcc;
    srcc.K = (const bf16_t*)(ws + W_KC) + (size_t)(bb * 4 + kvh) * 512 * 64;
    srcc.VT = (const bf16_t*)(ws + W_VCT) + (size_t)(bb * 4 + kvh) * 64 * 512;
    srcc.ldv = 512;
    const int nmax = (qmax_blk - 31) >> 4;
    const int ncs = nmax >= 0 ? (nmax >> 6) + 1 : 0;
    coop_tiles2x(srcc, ncs, true, LinIter{0},
        [&](int, int n0, const bf16_t* kl, const bf16_t* vl) {
            if (PV == 1) return;
            if (wactive) attn_tile64(q0, q1, kl, vl, n0, nhi >= 0, 0, nhi, m, l, o, c, Q);
        }, smem, tid);
    const float lcs = row_sum(l);
    const float inv_lc = lcs > 0.f ? 1.0f / lcs : 0.f;
#pragma unroll
    for (int db = 0; db < 4; ++db) outacc[db] += o[db] * (g_c * inv_lc);
#pragma unroll
    for (int i = 0; i < 8; ++i) imp[lane + 64 * i] = 0.f;
    if (lane < 16) msk[lane] = 0u;
    if (tid < 4) bun[tid] = 0u;
    {
        const float mu = m;
        float rprev = 0.f;
        coop_tiles2x(srcc, ncs, false, LinIter{0},
            [&](int, int n0, const bf16_t* kl, const bf16_t*) {
                if (!wactive) return;
#pragma unroll
                for (int sub = 0; sub < 4; ++sub) {
                    f32x4 sv = {0.f, 0.f, 0.f, 0.f};
                    sv = MFMA16(*(const bf16x8*)&kl[(sub * 16 + c) * KT_LD + Q * 8], q0, sv);
                    sv = MFMA16(*(const bf16x8*)&kl[(sub * 16 + c) * KT_LD + 32 + Q * 8], q1, sv);
                    float pr[4];
#pragma unroll
                    for (int j = 0; j < 4; ++j) {
                        const int n = n0 + sub * 16 + 4 * Q + j;
                        pr[j] = (16 * n + 31 <= qpos) ? fexp2(sv[j] - mu) * inv_lc : 0.f;
                        pr[j] += __builtin_bit_cast(float, __builtin_amdgcn_update_dpp(0, __builtin_bit_cast(int, pr[j]), 0xB1, 0xf, 0xf, true));
                        pr[j] += __builtin_bit_cast(float, __builtin_amdgcn_update_dpp(0, __builtin_bit_cast(int, pr[j]), 0x4E, 0xf, 0xf, true));
                    }
                    const float part = 2.f * (pr[0] + pr[1] + pr[2]) + pr[3];
                    const float rr = __shfl(pr[3], (lane + 48) & 63);
                    const float is = part + (Q == 0 ? rprev : rr);
                    rprev = rr;
                    if (gq == 0) imp[qi * 128 + ((n0 + sub * 16) >> 2) + Q] = is;
                }
            }, smem, tid);
    }
    wave_lds_sync();
    if (wactive) {
        const int cur = (qbase + wid * 4 + Q) >> 6;
        unsigned kk[8];
#pragma unroll
        for (int i = 0; i < 8; ++i) {
            const int blk = i * 16 + c;
            float x = imp[Q * 128 + blk];
            if (blk > cur) x = NEG_INF; else if (blk == 0 || blk == cur || blk == cur - 1) x = POS_INF;
            kk[i] = (f2ord(x) & 0xffffff80u) | (unsigned)(127 - blk);
        }
        const unsigned tk = top16_keys(kk, c);
        const int ti = 127 - (int)(tk & 127u);
        const bool finite_or_forced = (tk & 0xffffff80u) > (f2ord(NEG_INF) & 0xffffff80u);
        if (c < (SAMPLE ? 15 : 16) && finite_or_forced) atomicOr(&msk[Q * 4 + (ti >> 5)], 1u << (ti & 31));
    }
    wave_lds_sync();
    const unsigned mk0 = msk[qi * 4 + 0], mk1 = msk[qi * 4 + 1], mk2 = msk[qi * 4 + 2], mk3 = msk[qi * 4 + 3];
    unsigned wun[4];
#pragma unroll
    for (int w = 0; w < 4; ++w) wun[w] = __builtin_amdgcn_readfirstlane(msk[w] | msk[4 + w] | msk[8 + w] | msk[12 + w]);
    if (wactive && lane < 4) atomicOr(&bun[lane], lane == 0 ? wun[0] : (lane == 1 ? wun[1] : (lane == 2 ? wun[2] : wun[3])));
    __syncthreads();
    unsigned un[4];
#pragma unroll
    for (int w = 0; w < 4; ++w) un[w] = __builtin_amdgcn_readfirstlane(bun[w]);
    const int nsel = __builtin_popcount(un[0]) + __builtin_popcount(un[1]) + __builtin_popcount(un[2]) + __builtin_popcount(un[3]) + (SAMPLE ? 1 : 0);
    m = 0.f; l = 0.f;
#pragma unroll
    for (int i = 0; i < 4; ++i) o[i] = (f32x4){0.f, 0.f, 0.f, 0.f};
    {
        const BitIter keyf{un[0], un[1], un[2], un[3]};
        auto comp = [&](int, int key0, const bf16_t* kl, const bf16_t* vl) {
            if (!wactive) return;
            const int jb = key0 >> 6, w = jb >> 5, bit = jb & 31;
            const unsigned wu = w == 0 ? wun[0] : (w == 1 ? wun[1] : (w == 2 ? wun[2] : (w == 3 ? wun[3] : 1u)));
            if (!((wu >> bit) & 1u)) return;
            const unsigned mine = w == 0 ? mk0 : (w == 1 ? mk1 : (w == 2 ? mk2 : (w == 3 ? mk3 : 1u)));
            const bool mysel = (mine >> bit) & 1u;
            if (PV == 1) return;
            attn_tile64(q0, q1, kl, vl, key0, mysel, 0, qpos, m, l, o, c, Q);
        };
        if (!SAMPLE) {
            SrcBf src;
            src.K = (const bf16_t*)(ws + W_SELK) + (size_t)(b * 4 + kvh) * SEQ * 64;
            src.VT = (const bf16_t*)(ws + W_SELVT) + (size_t)(b * 4 + kvh) * 64 * SEQ;
            src.ldv = SEQ;
            coop_tiles2x(src, nsel, true, keyf, comp, smem, tid);
        } else {
            const int* pt = p.page_table + b * NPAGE;
            auto rf = [&](int tok, int which) -> const float* {
                tok = tok > PAST + 7 ? PAST + 7 : tok;
                if (tok < PAST) { const int page = pt[tok >> 7]; return p.cache_b_kv + ((size_t)(page * 128 + (tok & 127)) * 4 + 2 + which) * 256 + kvh * 64; }
                return p.out + O_BKVS + ((size_t)(b * 8 + tok - PAST) * 4 + 2 + which) * 256 + kvh * 64;
            };
            SrcF32<decltype(rf)> src{rf};
            coop_tiles(src, nsel, true, keyf, comp, Kl, VTl, tid);
        }
    }
    {
        const float ls = row_sum(l);
        const float inv = ls > 0.f ? 1.0f / ls : 0.f;
#pragma unroll
        for (int db = 0; db < 4; ++db) outacc[db] += o[db] * (g_s * inv);
    }
    m = 0.f; l = 0.f;
#pragma unroll
    for (int i = 0; i < 4; ++i) o[i] = (f32x4){0.f, 0.f, 0.f, 0.f};
    if (!SAMPLE) {
        SrcBf src;
        src.K = (const bf16_t*)(ws + W_WINK) + (size_t)(b * 4 + kvh) * SEQ * 64;
        src.VT = (const bf16_t*)(ws + W_WINVT) + (size_t)(b * 4 + kvh) * 64 * SEQ;
        src.ldv = SEQ;
        int klo = t0blk - 512; klo = klo < 0 ? 0 : klo; klo &= ~63;
        const int nws = ((t0blk + 15 - klo) >> 6) + 1;
        coop_tiles2x(src, nws, true, LinIter{klo},
            [&](int, int key0, const bf16_t* kl, const bf16_t* vl) {
                if (PV == 1) return;
                attn_tile64(q0, q1, kl, vl, key0, true, qpos - 512, qpos, m, l, o, c, Q);
            }, smem, tid);
    } else {
        auto rf = [&](int i, int which) -> const float* {
            i = i > 519 ? 519 : i;
            return i < 512 ? p.cache_b_win + ((size_t)(b * 512 + i) * 2 + which) * 256 + kvh * 64
                           : p.out + O_BWS + ((size_t)(b * 512 + i - 8) * 2 + which) * 256 + kvh * 64;
        };
        SrcF32<decltype(rf)> src{rf};
        coop_tiles(src, 9, true, LinIter{0},
            [&](int, int key0, const bf16_t* kl, const bf16_t* vl) {
                if (wactive) attn_tile64(q0, q1, kl, vl, key0, true, qpos - (PAST - 512) - 512, qpos - (PAST - 512), m, l, o, c, Q);
            }, Kl, VTl, tid);
    }
    {
        const float ls = row_sum(l);
        const float inv = ls > 0.f ? 1.0f / ls : 0.f;
#pragma unroll
        for (int db = 0; db < 4; ++db) outacc[db] += o[db] * (g_w * inv);
    }
    if (wactive) {
        bf16_t* OB = (bf16_t*)(ws + W_OB) + (size_t)trow * 1024 + hq * 64;
#pragma unroll
        for (int db = 0; db < 4; ++db) {
            u32x2 w; w.x = pk2(outacc[db][0], outacc[db][1]); w.y = pk2(outacc[db][2], outacc[db][3]);
            *(u32x2*)(OB + db * 16 + 4 * Q) = w;
        }
    }
}
template <int REP> DI void phase_nsa(const Params& p, unsigned char* smem) {
    const int tid = otid();
    unsigned* cnt = (unsigned*)(p.ws + W_CTL) + CTL_CNT_WORD + 64 * (4 + 8 * REP);
    int* sh_unit = (int*)(smem + 2 * ST2_BYTES + 288);
    const int NSU = BD * 4, NPU = NBP * 4 * 512;
    if (FLOAT_WORK && REP == 0) {
        const int nfl = (int)gridDim.x - (int)gridDim.x / 2, b0 = (int)gridDim.x / 2;
        if ((int)blockIdx.x >= b0) {
            const int bi = (int)blockIdx.x - b0;
            copy_shift_part(p.cache_a0, p.out + O_A1S, 128, 256, bi, nfl);
            copy_shift_part(p.cache_a1, p.out + O_A2S, 512, 256, bi, nfl);
            copy_shift_part(p.cache_a2, p.out + O_A3S, 2048, 256, bi, nfl);
            copy_shift_part(p.cache_b_win, p.out + O_BWS, 512, 128, bi, nfl);
        }
    }
    for (;;) {
        if (tid == 0) *sh_unit = (int)__hip_atomic_fetch_add(cnt, 1u, __ATOMIC_RELAXED, __HIP_MEMORY_SCOPE_AGENT);
        __syncthreads();
        const int u = __builtin_amdgcn_readfirstlane(*sh_unit);
        __syncthreads();
        if (u >= NSU + NPU) break;
        if (REP && PROBE_NSA_ONLY == 1 && u >= NSU) break;
        if (REP && PROBE_NSA_ONLY == 2 && u < NSU) continue;
        if (u < NSU) nsa_block_unit<true>(p, u, smem, tid); else nsa_block_unit<false, (REP ? PROBE_NSA_VARIANT : 0)>(p, u - NSU, smem, tid);
    }
}

struct SrcTiled {
    const bf16_t* K; const bf16_t* V;
    typedef TileRegsBf Regs;
    DI void load(Regs& r, int key0, int tid, bool) const {
        r.k0 = *(const bf16x8*)(K + (size_t)key0 * 64 + tid * 8); r.k1 = *(const bf16x8*)(K + (size_t)key0 * 64 + (tid + 256) * 8);
        r.v0 = *(const bf16x8*)(V + (size_t)key0 * 64 + tid * 8); r.v1 = *(const bf16x8*)(V + (size_t)key0 * 64 + (tid + 256) * 8);
    }
    DI void store(const Regs& r, bf16_t* Kl, bf16_t* Vl, int tid, bool) const {
        *(bf16x8*)&Kl[tid * 8] = r.k0; *(bf16x8*)&Kl[(tid + 256) * 8] = r.k1;
        *(bf16x8*)&Vl[tid * 8] = r.v0; *(bf16x8*)&Vl[(tid + 256) * 8] = r.v1;
    }
};
template <int NS>
DI void softmax_update(f32x4 (&s)[NS], float& m, float& l, f32x4 (&o)[4]) {
    float mx = NEG_INF;
#pragma unroll
    for (int i = 0; i < NS; ++i) mx = fmaxf(mx, fmaxf(fmaxf(s[i][0], s[i][1]), fmaxf(s[i][2], s[i][3])));
    if (__any(mx > LAZY_T)) {
        float mr = mx + m;
        mr = fmaxf(mr, __shfl_xor(mr, 16)); mr = fmaxf(mr, __shfl_xor(mr, 32));
        const float mn = fmaxf(m, mr), shift = mn - m, alpha = fexp2(-shift);
        l *= alpha; m = mn;
#pragma unroll
        for (int db = 0; db < 4; ++db) o[db] = o[db] * alpha;
#pragma unroll
        for (int i = 0; i < NS; ++i)
#pragma unroll
            for (int j = 0; j < 4; ++j) s[i][j] -= shift;
    }
#pragma unroll
    for (int i = 0; i < NS; ++i)
#pragma unroll
        for (int j = 0; j < 4; ++j) { s[i][j] = fexp2(s[i][j]); l += s[i][j]; }
}
DI void attn_tile64_tiled(const bf16x8& q0, const bf16x8& q1, const bf16_t* Kl, const bf16_t* Vl, int key0, int klo, int khi,
                          float& m, float& l, f32x4 (&o)[4], int lane) {
    const int Q = lane >> 4;
    f32x4 s[4];
#pragma unroll
    for (int sub = 0; sub < 4; ++sub) {
        s[sub] = (f32x4){-m, -m, -m, -m};
        s[sub] = MFMA16(*(const bf16x8*)&Kl[((sub * 2 + 0) * 64 + lane) * 8], q0, s[sub]);
        s[sub] = MFMA16(*(const bf16x8*)&Kl[((sub * 2 + 1) * 64 + lane) * 8], q1, s[sub]);
    }
    if (__any(key0 < klo || key0 + 63 > khi)) {
        const unsigned span = (unsigned)(khi - klo);
        const int kb = key0 + 4 * Q - klo;
#pragma unroll
        for (int sub = 0; sub < 4; ++sub)
#pragma unroll
            for (int j = 0; j < 4; ++j) if ((unsigned)(kb + sub * 16 + j) > span) s[sub][j] = NEG_INF;
    }
    softmax_update<4>(s, m, l, o);
#pragma unroll
    for (int half = 0; half < 2; ++half) {
        const bf16x8 pb = pack8(s[2 * half][0], s[2 * half][1], s[2 * half][2], s[2 * half][3], s[2 * half + 1][0], s[2 * half + 1][1], s[2 * half + 1][2], s[2 * half + 1][3]);
#pragma unroll
        for (int db = 0; db < 4; ++db) o[db] = MFMA16(*(const bf16x8*)&Vl[((half * 4 + db) * 64 + lane) * 8], pb, o[db]);
    }
}
DI void attn_tile32_regs0(const bf16x8& q0, const bf16x8& q1, const KVregs& F, int key0, int klo, int khi, float& m, float& l, f32x4 (&o)[4], int Q) {
    f32x4 s[2];
    s[0] = (f32x4){-m, -m, -m, -m}; s[1] = s[0];
    s[0] = MFMA16(F.k[0], q0, s[0]); s[0] = MFMA16(F.k[1], q1, s[0]);
    s[1] = MFMA16(F.k[2], q0, s[1]); s[1] = MFMA16(F.k[3], q1, s[1]);
    {
        const unsigned span = (unsigned)(khi - klo);
        const int kb = key0 + 4 * Q - klo;
#pragma unroll
        for (int sub = 0; sub < 2; ++sub)
#pragma unroll
            for (int j = 0; j < 4; ++j) if ((unsigned)(kb + sub * 16 + j) > span) s[sub][j] = NEG_INF;
    }
    softmax_update<2>(s, m, l, o);
    const bf16x8 pb = pack8(s[0][0], s[0][1], s[0][2], s[0][3], s[1][0], s[1][1], s[1][2], s[1][3]);
    o[0] = MFMA16(F.v[0], pb, o[0]); o[1] = MFMA16(F.v[1], pb, o[1]); o[2] = MFMA16(F.v[2], pb, o[2]); o[3] = MFMA16(F.v[3], pb, o[3]);
}
DI void attnA_prompt_block(const Params& p, int u, unsigned char* smem, int tid) {
    const int lane = tid & 63, wid = tid >> 6, c = lane & 15, Q = lane >> 4;
    const int r0 = u & 3, tb = (u >> 2) & 31, head = (u >> 7) & 7, b = u >> 10;
    const int r = r0 + 4 * wid;
    const int trow = b * SEQ + tb * 256 + r + 16 * c;
    const bf16_t* QA = (const bf16_t*)(p.ws + W_QA) + (size_t)trow * 1536 + head * 64 + Q * 8;
    float m = 0.f, l = 0.f; f32x4 o[4];
#pragma unroll
    for (int i = 0; i < 4; ++i) o[i] = (f32x4){0.f, 0.f, 0.f, 0.f};
    {
        const bf16x8 q0 = *(const bf16x8*)(QA), q1 = *(const bf16x8*)(QA + 32);
        SrcTiled src;
        src.K = (const bf16_t*)(p.ws + W_KA) + (size_t)((0 * 2 + b) * 8 + head) * SEQ * 64;
        src.V = (const bf16_t*)(p.ws + W_VAT) + (size_t)((0 * 2 + b) * 8 + head) * SEQ * 64;
        const int mi = tb * 256 + r + 16 * c;
        int lo = tb * 256 + r0 - 128; lo = lo < 0 ? 0 : lo; lo &= ~63;
        const int hi = tb * 256 + r0 + 12 + 240;
        const int wlo = tb * 256 + r - 128, whi = tb * 256 + r + 240;
        coop_tiles2x(src, ((hi - lo) >> 6) + 1, true, LinIter{lo},
            [&](int, int key0, const bf16_t* kl, const bf16_t* vl) {
                if (key0 + 63 < wlo || key0 > whi) return;
                attn_tile64_tiled(q0, q1, kl, vl, key0, mi - 128, mi, m, l, o, lane);
            }, smem, tid);
    }
    {
        const bf16x8 q0 = *(const bf16x8*)(QA + 512), q1 = *(const bf16x8*)(QA + 512 + 32);
        constexpr int L = SEQ >> 2;
        SrcTiled src;
        src.K = (const bf16_t*)(p.ws + W_KA) + ((size_t)((1 * 2 + b) * 8 + head) * SEQ + (size_t)r0 * L) * 64;
        src.V = (const bf16_t*)(p.ws + W_VAT) + ((size_t)((1 * 2 + b) * 8 + head) * SEQ + (size_t)r0 * L) * 64;
        const int mq0 = tb * 64 + wid, mi = mq0 + 4 * c;
        int lo = tb * 64 - 128; lo = lo < 0 ? 0 : lo; lo &= ~63;
        const int hi = tb * 64 + 3 + 60;
        coop_tiles2x(src, ((hi - lo) >> 6) + 1, true, LinIter{lo},
            [&](int, int key0, const bf16_t* kl, const bf16_t* vl) {
                if (key0 + 63 < mq0 - 128 || key0 > mq0 + 60) return;
                attn_tile64_tiled(q0, q1, kl, vl, key0, mi - 128, mi, m, l, o, lane);
            }, smem, tid);
    }
    {
        const bf16x8 q0 = *(const bf16x8*)(QA + 1024), q1 = *(const bf16x8*)(QA + 1024 + 32);
        constexpr int L = SEQ >> 4;
        KVtiled kv;
        kv.K = (const bf16_t*)(p.ws + W_KA) + ((size_t)((2 * 2 + b) * 8 + head) * SEQ + (size_t)r * L) * 64;
        kv.VT = (const bf16_t*)(p.ws + W_VAT) + ((size_t)((2 * 2 + b) * 8 + head) * SEQ + (size_t)r * L) * 64;
        kv.lane = lane;
        const int mq0 = tb * 16, mi = mq0 + c;
        int klo = mq0 - 128; klo = klo < 0 ? 0 : klo; klo &= ~31;
        const int khi = mq0 + 15;
        KVregs F0, F1;
        F0.load(kv, klo);
        for (int key0 = klo; key0 <= khi; key0 += 64) {
            const bool has1 = key0 + 32 <= khi;
            if (has1) F1.load(kv, key0 + 32);
            attn_tile32_regs0(q0, q1, F0, key0, mi - 128, mi, m, l, o, Q);
            if (has1) {
                if (key0 + 64 <= khi) F0.load(kv, key0 + 64);
                attn_tile32_regs0(q0, q1, F1, key0 + 32, mi - 128, mi, m, l, o, Q);
            }
        }
    }
    const float inv = 1.0f / row_sum(l);
    bf16_t* OA = (bf16_t*)(p.ws + W_OA) + (size_t)trow * 512 + head * 64;
#pragma unroll
    for (int db = 0; db < 4; ++db) {
        u32x2 w; w.x = pk2(o[db][0] * inv, o[db][1] * inv); w.y = pk2(o[db][2] * inv, o[db][3] * inv);
        *(u32x2*)(OA + db * 16 + 4 * Q) = w;
    }
}
template <int REP> DI void phase_attnA2(const Params& p, unsigned char* smem) {
    const int tid = otid();
    int* sh_unit = (int*)(smem + 2 * ST2_BYTES + 288);
    unsigned* cnts = (unsigned*)(p.ws + W_CTL) + CTL_CNT_WORD + 64 * (7 + 8 * REP);
    unsigned* cntp = (unsigned*)(p.ws + W_CTL) + CTL_CNT_WORD + 64 * (0 + 8 * REP);
    if (FLOAT_WORK && REP == 0) {
        const int nfl = (int)gridDim.x - (int)gridDim.x / 2, b0 = (int)gridDim.x / 2;
        if ((int)blockIdx.x >= b0) {
            unsigned char* ws = p.ws;
            const int bi = (int)blockIdx.x - b0;
            (void)bi; (void)ws;
        }
    }
    for (int pass = 0; pass < 2; ++pass) {
        const int nunits = pass == 0 ? BD * 8 : NBP * 8 * 32 * 4;
        for (;;) {
            if (tid == 0) *sh_unit = (int)__hip_atomic_fetch_add(pass == 0 ? cnts : cntp, 1u, __ATOMIC_RELAXED, __HIP_MEMORY_SCOPE_AGENT);
            __syncthreads();
            const int u = __builtin_amdgcn_readfirstlane(*sh_unit);
            __syncthreads();
            if (u >= nunits) break;
            if (pass == 0) attnA_sample_block(p, u, smem, tid); else attnA_prompt_block(p, u, smem, tid);
        }
    }
}

template <int PH, int REP = 0> DI void run_phase(const Params& p, unsigned char* smem) {
    unsigned char* ws = p.ws;
    const float* XRf = (const float*)(ws + W_XR);
    if (PH == 0) phase_prologue<(REP ? PROBE_P0_VARIANT : 0)>(p, smem);
    else if (PH == 1) gemm_run_i8<1>(p, ws + W_XQ, (const float*)(ws + W_SA), ws + W_WTIN, (const float*)(ws + W_SWIN), N_IN / 128, smem);
    else if (PH == 2) phase_attnA2<REP>(p, smem);
    else if (PH == 3) gemm_run<3>(p, (const bf16_t*)(ws + W_OA), (const bf16_t*)(ws + W_WTOA), 512, 1024 / 128, smem);
    else if (PH == 4) norm_rows_q8(XRf, XRf + (size_t)MP * D, ws + W_XQ, (float*)(ws + W_SA));
    else if (PH == 5) gemm_run_i8<5>(p, ws + W_XQ, (const float*)(ws + W_SA), ws + W_WTPQ, (const float*)(ws + W_SWPQ), N_PQ / 128, smem);
    else if (PH == 6) phase_peerA<0, REP>(p, smem);
    else if (PH == 7) phase_peerB<0, REP>(p, smem);
    else if (PH == 8) gemm_run_i8<8>(p, ws + W_XQ, (const float*)(ws + W_SA), ws + W_WTKVQG, (const float*)(ws + W_SWKV), N_KVQG / 128, smem);
    else if (PH == 9) phase_compress<REP>(p, smem);
    else if (PH == 10) phase_nsa<REP>(p, smem);
    else if (PH == 11) gemm_run<11>(p, (const bf16_t*)(ws + W_OB), (const bf16_t*)(ws + W_WTOB), 1024, 1024 / 128, smem);
    else if (PH == 12) norm_rows_q8(XRf, XRf + (size_t)MP * D, ws + W_XQ, (float*)(ws + W_SA));
    else if (PH == 13) gemm_run_i8<6>(p, ws + W_XQ, (const float*)(ws + W_SA), ws + W_WTPQ + (size_t)N_PQ * 1024, (const float*)(ws + W_SWPQ) + N_PQ, N_PQ / 128, smem);
    else if (PH == 14) phase_peerA<1, REP>(p, smem);
    else if (PH == 15) phase_peerB<1, REP>(p, smem);
}
constexpr int NPHASE = 16;

#if FUSED
__global__ void __launch_bounds__(NTHREADS, 2) yoco_fwd(Params p) {
    __shared__ __attribute__((aligned(16))) unsigned char smem[SMEM_BYTES];
    __shared__ uint4 xb_words;
    if (threadIdx.x == 0) xb_words = make_uint4(0u, 0u, 0u, 0u);
    __syncthreads();
    XcdBarrier bar = xcd_barrier_post((unsigned*)(p.ws + W_CTL), (volatile LAS unsigned*)&xb_words);
#define PHX(i) do { if (PROBE_DUP & (1 << (i))) { run_phase<i, 1>(p, smem); xcd_barrier(bar); } run_phase<i, 0>(p, smem); if ((i) < NPHASE - 1) xcd_barrier(bar); } while (0)
    PHX(0); PHX(1); PHX(2); PHX(3); PHX(4); PHX(5); PHX(6); PHX(7); PHX(8); PHX(9); PHX(10); PHX(11); PHX(12); PHX(13); PHX(14); PHX(15);
}
#else
template <int PH> __global__ void __launch_bounds__(NTHREADS, 2) yoco_phase(Params p) {
    __shared__ __attribute__((aligned(16))) unsigned char smem[SMEM_BYTES];
    run_phase<PH>(p, smem);
}
#endif

extern "C" void kernel_launch(void* const* d_in, const int* in_sizes, int n_in, void* d_out, int out_size, void* d_ws, size_t ws_size, hipStream_t stream) {
    (void)in_sizes; (void)n_in; (void)out_size; (void)ws_size;
    Params p{};
    p.x_prompt = (const float*)d_in[0]; p.x_sample = (const float*)d_in[1];
    p.cache_a0 = (const float*)d_in[2]; p.cache_a1 = (const float*)d_in[3]; p.cache_a2 = (const float*)d_in[4];
    p.cache_b_kv = (const float*)d_in[5]; p.cache_b_win = (const float*)d_in[6]; p.page_table = (const int*)d_in[7];
    p.g_mix = (const float*)d_in[8]; p.g_ffn = (const float*)d_in[9]; p.w_in_a = (const float*)d_in[10]; p.w_o_a = (const float*)d_in[11];
    p.g_kv = (const float*)d_in[12]; p.w_kv_b = (const float*)d_in[13]; p.w_cmp1 = (const float*)d_in[14]; p.w_cmp2 = (const float*)d_in[15];
    p.pe_cmp = (const float*)d_in[16]; p.w_qg_b = (const float*)d_in[17]; p.b_gate_b = (const float*)d_in[18]; p.w_o_b = (const float*)d_in[19];
    p.w_peer_q = (const float*)d_in[20]; p.peer_subkeys = (const float*)d_in[21]; p.peer_u = (const float*)d_in[22]; p.peer_v = (const float*)d_in[23];
    p.g_final = (const float*)d_in[24];
    p.out = (float*)d_out; p.ws = (unsigned char*)d_ws;
    hipMemsetAsync(d_ws, 0, 262144, stream);
#if FUSED
    static int grid = 0;
    if (!grid) {
        int dev = 0, cus = 0, per_cu = 0;
        hipGetDevice(&dev);
        hipDeviceGetAttribute(&cus, hipDeviceAttributeMultiprocessorCount, dev);
        hipOccupancyMaxActiveBlocksPerMultiprocessor(&per_cu, (const void*)yoco_fwd, NTHREADS, 0);
        int use = per_cu < 2 ? per_cu : 2; if (use < 1) use = 1;
        grid = cus * use;
    }
    hipLaunchKernelGGL(yoco_fwd, dim3(grid), dim3(NTHREADS), 0, stream, p);
#else
    const int grid = 512;
#define LAUNCH_PH(i) hipLaunchKernelGGL(yoco_phase<i>, dim3(grid), dim3(NTHREADS), 0, stream, p)
    LAUNCH_PH(0); LAUNCH_PH(1); LAUNCH_PH(2); LAUNCH_PH(3); LAUNCH_PH(4); LAUNCH_PH(5); LAUNCH_PH(6);
    LAUNCH_PH(7); LAUNCH_PH(8); LAUNCH_PH(9); LAUNCH_PH(10); LAUNCH_PH(11); LAUNCH_PH(12); LAUNCH_PH(13); LAUNCH_PH(14); LAUNCH_PH(15);
#endif
}
```
